# Optimizing an MI355X kernel written in HIP

```python
import math
import jax, jax.numpy as jnp
from jax import lax
import numpy as np


D_MODEL = 1024
BATCH = 8
SEQ = 4096
DEPTH = 1

D_MIX = D_MODEL
D_MLSTM = D_MIX // 2
D_DIFF = D_MIX - D_MLSTM
ML_HEADS = 4
ML_HD = D_MLSTM // ML_HEADS
CONV_W = 4
CHUNK = 128
DA_HEADS = 4
DA_VD = D_DIFF // DA_HEADS
DA_QD = DA_VD // 2
Q_BLOCK = 128
REL_BUCKETS = 32
REL_MAX_DIST = 128
N_GROUPS = 4
EXP_PER_GROUP = 8
N_EXPERTS = N_GROUPS * EXP_PER_GROUP
TOP_K_FINE = 2
D_FF_EXP = 512
EPS = 1e-6
SUBLN_EPS = 1e-5
IN_COLS = 3 * D_MLSTM + 3 * D_DIFF

kernel_name = 'hybrid_mlstm_diffattn_hmoe'


def rmsnorm(x, g, eps=EPS):
    xf = x.astype(jnp.float32)
    y = xf * lax.rsqrt(jnp.mean(xf * xf, axis=-1, keepdims=True) + eps)
    return (y * g.astype(jnp.float32)).astype(x.dtype)


def head_layernorm(h, g):
    mu = jnp.mean(h, axis=-1, keepdims=True)
    var = jnp.mean(jnp.square(h - mu), axis=-1, keepdims=True)
    return (h - mu) * lax.rsqrt(var + EPS) * g.astype(jnp.float32)


def causal_conv(x, w, b):
    c = x.shape[-1]
    y = lax.conv_general_dilated(x, w[:, None, :].astype(x.dtype), window_strides=(1,),
                                 padding=[(CONV_W - 1, 0)],
                                 dimension_numbers=('NWC', 'WIO', 'NWC'),
                                 feature_group_count=c)
    return y + b.astype(x.dtype)


def mlstm_chunkwise(q, k, v, i_pre, logf):
    bsz, s, nh, d = q.shape
    nc = s // CHUNK
    def chunks(t):
        return t.reshape(bsz, nc, CHUNK, nh, d).transpose(1, 0, 3, 2, 4)
    def gchunks(t):
        return t.reshape(bsz, nc, CHUNK, nh).transpose(1, 0, 3, 2)
    tril = jnp.tril(jnp.ones((CHUNK, CHUNK), dtype=bool))

    def step(carry, xs):
        cmat, nvec, m = carry
        qc, kc, vc, ic, fc = xs
        b = jnp.cumsum(fc, axis=-1)
        inter = b + m[..., None]
        dmat = jnp.where(tril, b[..., :, None] - b[..., None, :] + ic[..., None, :], -jnp.inf)
        m_t = jnp.maximum(inter, jnp.max(dmat, axis=-1))
        w = jnp.exp(dmat - m_t[..., None]) * jnp.einsum('bhtd,bhsd->bhts', qc, kc)
        sp = jnp.exp(inter - m_t)
        num = sp[..., None] * jnp.einsum('bhtk,bhvk->bhtv', qc, cmat) + jnp.einsum('bhts,bhsv->bhtv', w, vc)
        den = sp * jnp.einsum('bhtk,bhk->bht', qc, nvec) + jnp.sum(w, axis=-1)
        h = num / jnp.maximum(jnp.abs(den), jnp.exp(-m_t))[..., None]
        b_end = b[..., -1]
        g = b_end[..., None] - b + ic
        m_new = jnp.maximum(b_end + m, jnp.max(g, axis=-1))
        wk = jnp.exp(g - m_new[..., None])
        decay = jnp.exp(b_end + m - m_new)
        c_new = decay[..., None, None] * cmat + jnp.einsum('bhs,bhsv,bhsk->bhvk', wk, vc, kc)
        n_new = decay[..., None] * nvec + jnp.einsum('bhs,bhsk->bhk', wk, kc)
        return (c_new, n_new, m_new), h

    init = (jnp.zeros((bsz, nh, d, d), jnp.float32), jnp.zeros((bsz, nh, d), jnp.float32),
            jnp.zeros((bsz, nh), jnp.float32))
    _, hs = lax.scan(step, init, (chunks(q), chunks(k), chunks(v), gchunks(i_pre), gchunks(logf)))
    return hs.transpose(1, 0, 3, 2, 4).reshape(bsz, s, nh, d)


def mlstm_group(c, v, z, conv_w, conv_b, w_mq, w_mk, w_mgate, b_mgate, m_norm_g, m_skip):
    bsz, s, _ = c.shape
    c_act = jax.nn.silu(causal_conv(c, conv_w, conv_b))
    ch = c_act.reshape(bsz, s, ML_HEADS, ML_HD)
    q = jnp.einsum('bshd,hde->bshe', ch, w_mq)
    k = jnp.einsum('bshd,hde->bshe', ch, w_mk)
    vh = v.reshape(bsz, s, ML_HEADS, ML_HD)
    gin = jnp.concatenate([q.reshape(bsz, s, -1), k.reshape(bsz, s, -1), v], axis=-1)
    gates = (gin @ w_mgate).astype(jnp.float32) + b_mgate.astype(jnp.float32)
    i_pre = gates[..., :ML_HEADS]
    logf = jax.nn.log_sigmoid(gates[..., ML_HEADS:])
    h = mlstm_chunkwise(q.astype(jnp.float32), (k * (ML_HD ** -0.5)).astype(jnp.float32),
                        vh.astype(jnp.float32), i_pre, logf)
    h = head_layernorm(h, m_norm_g.reshape(ML_HEADS, ML_HD)).reshape(bsz, s, D_MLSTM)
    h = h + m_skip.astype(jnp.float32) * c_act.astype(jnp.float32)
    o = jax.nn.sigmoid(z.astype(jnp.float32))
    return (o * h).astype(c.dtype)


def rel_bucket(qpos, kpos):
    n = jnp.maximum(qpos[:, None] - kpos[None, :], 0)
    max_exact = REL_BUCKETS // 2
    large = max_exact + (jnp.log(jnp.maximum(n, 1).astype(jnp.float32) / max_exact)
                         / math.log(REL_MAX_DIST / max_exact) * (REL_BUCKETS - max_exact)).astype(jnp.int32)
    large = jnp.minimum(large, REL_BUCKETS - 1)
    return jnp.where(n < max_exact, n, large)


def diff_attention(q, k, v, lam, rel_bias):
    bsz, s = q.shape[0], q.shape[1]
    nb = s // Q_BLOCK
    scale = DA_QD ** -0.5
    qb = jnp.moveaxis(q.reshape(bsz, nb, Q_BLOCK, DA_HEADS, 2, DA_QD), 1, 0)
    kpos = jnp.arange(s)

    def block(args):
        q_blk, bi = args
        qpos = bi * Q_BLOCK + jnp.arange(Q_BLOCK)
        bias = rel_bias[rel_bucket(qpos, kpos)].transpose(2, 0, 1).astype(jnp.float32)
        mask = kpos[None, :] <= qpos[:, None]
        logits = jnp.einsum('bqhcd,bkhcd->bchqk', q_blk, k).astype(jnp.float32) * scale + bias[None, None]
        p = jax.nn.softmax(jnp.where(mask, logits, -jnp.inf), axis=-1)
        a = p[:, 0] - lam * p[:, 1]
        return jnp.einsum('bhqk,bkhd->bqhd', a.astype(v.dtype), v)

    out = lax.map(block, (qb, jnp.arange(nb)))
    return jnp.moveaxis(out, 0, 1).reshape(bsz, s, DA_HEADS, DA_VD)


def hier_moe(h, w_rg, b_rg, w_re, b_re, w_eg, w_eu, w_ed):
    bsz, s, d = h.shape
    t = h.reshape(-1, d)
    lg = (t @ w_rg).astype(jnp.float32) + b_rg.astype(jnp.float32)
    pg = jax.nn.softmax(lg, axis=-1)
    _, g_idx = lax.top_k(lg, 1)
    pg_sel = jnp.take_along_axis(pg, g_idx, axis=-1)
    le = jnp.einsum('nd,dge->nge', t, w_re).astype(jnp.float32) + b_re.astype(jnp.float32)
    le_sel = jnp.take_along_axis(le, g_idx[:, :, None], axis=1)[:, 0]
    top_v, top_i = lax.top_k(le_sel, TOP_K_FINE)
    pw = jax.nn.softmax(top_v, axis=-1)
    eid = g_idx * EXP_PER_GROUP + top_i
    gates = jnp.sum(jax.nn.one_hot(eid, N_EXPERTS, dtype=jnp.float32) * (pg_sel * pw)[..., None], axis=1)
    gates = gates.astype(t.dtype)
    out = jnp.zeros_like(t)
    for e in range(N_EXPERTS):
        hid = jax.nn.silu(t @ w_eg[e]) * (t @ w_eu[e])
        out = out + gates[:, e:e + 1] * (hid @ w_ed[e])
    return out.reshape(bsz, s, d)


def setup_inputs(seed: int = 0) -> dict:
    key = jax.random.key(seed)
    ks = jax.random.split(key, 32)
    f32 = jnp.float32
    def nrm(k, shape, sc):
        return jax.random.normal(k, shape, f32) * sc
    L = DEPTH
    b_i = nrm(ks[7], (L, ML_HEADS), 0.1)
    b_f = jnp.linspace(3.0, 6.0, ML_HEADS, dtype=f32)[None, :] + nrm(ks[8], (L, ML_HEADS), 0.01)
    return {
        'x': nrm(ks[0], (BATCH, SEQ, D_MODEL), 1.0),
        'w_in': nrm(ks[1], (L, D_MODEL, IN_COLS), D_MODEL ** -0.5),
        'conv_w': nrm(ks[2], (L, CONV_W, D_MLSTM), CONV_W ** -0.5),
        'conv_b': nrm(ks[3], (L, D_MLSTM), 0.01),
        'w_mq': nrm(ks[4], (L, ML_HEADS, ML_HD, ML_HD), ML_HD ** -0.5),
        'w_mk': nrm(ks[5], (L, ML_HEADS, ML_HD, ML_HD), ML_HD ** -0.5),
        'w_mgate': nrm(ks[6], (L, 3 * D_MLSTM, 2 * ML_HEADS), 0.1 * (3 * D_MLSTM) ** -0.5),
        'b_mgate': jnp.concatenate([b_i, b_f], axis=-1),
        'm_norm_g': 1.0 + nrm(ks[9], (L, D_MLSTM), 0.02),
        'm_skip': 1.0 + nrm(ks[10], (L, D_MLSTM), 0.02),
        'lambda_qk': nrm(ks[11], (L, 4, DA_QD), 0.1),
        'da_norm_g': 1.0 + nrm(ks[12], (L, DA_VD), 0.02),
        'rel_bias': nrm(ks[13], (REL_BUCKETS, DA_HEADS), 0.2),
        'w_out': nrm(ks[14], (L, D_MIX, D_MODEL), D_MIX ** -0.5),
        'norm1_g': 1.0 + nrm(ks[15], (L, D_MODEL), 0.02),
        'norm2_g': 1.0 + nrm(ks[16], (L, D_MODEL), 0.02),
        'w_rg': nrm(ks[17], (L, D_MODEL, N_GROUPS), D_MODEL ** -0.5),
        'b_rg': nrm(ks[18], (L, N_GROUPS), 0.01),
        'w_re': nrm(ks[19], (L, D_MODEL, N_GROUPS, EXP_PER_GROUP), D_MODEL ** -0.5),
        'b_re': nrm(ks[20], (L, N_GROUPS, EXP_PER_GROUP), 0.01),
        'w_eg': nrm(ks[21], (L, N_EXPERTS, D_MODEL, D_FF_EXP), D_MODEL ** -0.5),
        'w_eu': nrm(ks[22], (L, N_EXPERTS, D_MODEL, D_FF_EXP), D_MODEL ** -0.5),
        'w_ed': nrm(ks[23], (L, N_EXPERTS, D_FF_EXP, D_MODEL), D_FF_EXP ** -0.5),
        'normf_g': 1.0 + nrm(ks[24], (D_MODEL,), 0.02),
    }


def reference(x, w_in, conv_w, conv_b, w_mq, w_mk, w_mgate, b_mgate, m_norm_g, m_skip,
              lambda_qk, da_norm_g, rel_bias, w_out, norm1_g, norm2_g, w_rg, b_rg, w_re, b_re,
              w_eg, w_eu, w_ed, normf_g):
    bsz, s, _ = x.shape
    splits = [D_MLSTM, 2 * D_MLSTM, 3 * D_MLSTM, 3 * D_MLSTM + D_DIFF, 3 * D_MLSTM + 2 * D_DIFF]
    for l in range(DEPTH):
        lam_init = 0.8 - 0.6 * math.exp(-0.3 * l)
        h = rmsnorm(x, norm1_g[l])
        proj = h @ w_in[l]
        c, vm, z, qd, kd, vd = jnp.split(proj, splits, axis=-1)
        y_m = mlstm_group(c, vm, z, conv_w[l], conv_b[l], w_mq[l], w_mk[l], w_mgate[l], b_mgate[l],
                          m_norm_g[l], m_skip[l])
        lq = lambda_qk[l].astype(jnp.float32)
        lam = jnp.exp(jnp.dot(lq[0], lq[1])) - jnp.exp(jnp.dot(lq[2], lq[3])) + lam_init
        y_d = diff_attention(qd.reshape(bsz, s, DA_HEADS, 2, DA_QD), kd.reshape(bsz, s, DA_HEADS, 2, DA_QD),
                             vd.reshape(bsz, s, DA_HEADS, DA_VD), lam, rel_bias)
        y_d = (rmsnorm(y_d, da_norm_g[l], SUBLN_EPS) * (1.0 - lam_init)).reshape(bsz, s, D_DIFF)
        x = x + jnp.concatenate([y_m, y_d.astype(x.dtype)], axis=-1) @ w_out[l]
        h2 = rmsnorm(x, norm2_g[l])
        x = x + hier_moe(h2, w_rg[l], b_rg[l], w_re[l], b_re[l], w_eg[l], w_eu[l], w_ed[l])
    return rmsnorm(x, normf_g)
```

```cpp
#define EN_MIX_D 1
#define EN_MIX_M 1
#define EN_MOE 1
#include <hip/hip_runtime.h>
#include <cstdio>
#include <cstdint>
#ifndef PROBE_CONVREP
#define PROBE_CONVREP 1
#endif
#ifndef REP_MASK
#define REP_MASK 0
#endif
#define REPS(k) (((REP_MASK >> (k)) & 1) ? (((args.rep_mask >> (k)) & 1) + 1) : 1)

namespace pg8 {
#define PG8_LAS __attribute__((address_space(3)))
typedef unsigned short bf16_t;
typedef short bf16x8 __attribute__((ext_vector_type(8)));
typedef float f32x4 __attribute__((ext_vector_type(4)));
typedef unsigned u32x4 __attribute__((ext_vector_type(4)));
constexpr int BM = 256, BK = 64, HALF = 128, HTB = HALF * BK * 2  , STAGE_BYTES = 8 * HTB, NXCD = 8, WGM = 8;

__host__ __device__ __forceinline__ int lds_byte(int r, int c) { const int st = (r >> 4) * 2 + (c >> 5), rr = r & 15, cc = c & 31, ob = rr * 64 + cc * 2; return st * 1024 + (ob ^ (((ob >> 9) & 1) << 5)); }
__host__ __device__ __forceinline__ void stage_rc(int b, int& R, int& C) { const int st = b / 1024, sb = b % 1024, swz = sb ^ (((sb >> 9) & 1) << 5); R = (st >> 1) * 16 + swz / 64; C = (st & 1) * 32 + (swz % 64) / 2; }
__host__ __device__ __forceinline__ int perm32(int rho) { const int n = rho >> 4, i = rho & 15; return 8 * (i >> 2) + 4 * n + (i & 3); }

struct Unit { int pm, pn, e; };
struct Gemm { const bf16_t* A; const bf16_t* Bt; int M, N, K; size_t bstride; };

struct StaticOrder {
    int nM, nN, nwg, G, c;
    __host__ __device__ void init(int M, int N, int G_, int c_) { nM = M / BM; nN = N / BM; nwg = nM * nN; G = G_; c = c_; }
    __host__ __device__ bool next(int i, Unit& u) const {
        const long L = (long)i * G + c; if (L >= nwg) return false;
        int wgid = (int)L; { const int q = nwg / NXCD, r = nwg % NXCD, xcd = wgid % NXCD, off = wgid / NXCD; wgid = (xcd < r ? xcd * (q + 1) : r * (q + 1) + (xcd - r) * q) + off; }
        const int nig = WGM * nN, gid = wgid / nig, fm = gid * WGM, gsz = (nM - fm) < WGM ? (nM - fm) : WGM;
        u.pm = fm + ((wgid % nig) % gsz); u.pn = (wgid % nig) / gsz; u.e = 0; return true;
    }
    __device__ __forceinline__ void a_ready(const Unit&) const {}
    __device__ __forceinline__ void done(const Unit&) const {}
};


struct GroupedOrder {
    int nM, nN, nwg, G, c; const PG8_LAS int* tile_e;
    __device__ void init(int nM_, int N, int G_, int c_, const PG8_LAS int* te) { nM = nM_; nN = N / BM; nwg = nM * nN; G = G_; c = c_; tile_e = te; }
    __device__ bool next(int i, Unit& u) const {
        const long L = (long)i * G + c; if (L >= nwg) return false;
        int wgid = (int)L; { const int q = nwg / NXCD, r = nwg % NXCD, xcd = wgid % NXCD, off = wgid / NXCD; wgid = (xcd < r ? xcd * (q + 1) : r * (q + 1) + (xcd - r) * q) + off; }
        const int nig = WGM * nN, gid = wgid / nig, fm = gid * WGM, gsz = (nM - fm) < WGM ? (nM - fm) : WGM;
        u.pm = fm + ((wgid % nig) % gsz); u.pn = (wgid % nig) / gsz; u.e = __builtin_amdgcn_readfirstlane(tile_e[u.pm]); return true;
    }
    __device__ __forceinline__ void a_ready(const Unit&) const {}
    __device__ __forceinline__ void done(const Unit&) const {}
};

__device__ __forceinline__ unsigned cvt_pk_bf16(float lo, float hi) { unsigned r; asm volatile("v_cvt_pk_bf16_f32 %0, %1, %2" : "=v"(r) : "v"(lo), "v"(hi)); return r; }

__device__ __forceinline__ void pack_fp8x8(const float (&v)[8], unsigned& lo, unsigned& hi) {
    int a = 0, b = 0; a = __builtin_amdgcn_cvt_pk_fp8_f32(v[0], v[1], a, false); a = __builtin_amdgcn_cvt_pk_fp8_f32(v[2], v[3], a, true);
    b = __builtin_amdgcn_cvt_pk_fp8_f32(v[4], v[5], b, false); b = __builtin_amdgcn_cvt_pk_fp8_f32(v[6], v[7], b, true); lo = (unsigned)a; hi = (unsigned)b; }
typedef unsigned u32x2 __attribute__((ext_vector_type(2)));
struct EpiBf16S {
    static constexpr bool PERM = true, AFTER_DRAIN = false, WIDE = true, HAS_PRE = false;
    bf16_t* O; int ldc; int split_cols; size_t split_stride; int scale_tile; float scale0; int sig_tile;
    __device__ __forceinline__ void operator()(const f32x4 (&acc)[2][2][4][2], const Unit& u, int wr, int wc, int fr, int fq) const {
        const int row0 = u.pm * BM + wr * 64 + fr; int colt = u.pn * BM; bf16_t* base = O; bool sig = false;
        float sc = 1.f; if (split_cols) { const int t = colt / split_cols; base += (size_t)t * split_stride; colt -= t * split_cols; if (t == scale_tile) sc = scale0; sig = (t == sig_tile); }
        const int col0 = colt + wc * 64 + 16 * fq;
#pragma unroll
        for (int ai = 0; ai < 2; ++ai)
#pragma unroll
            for (int m = 0; m < 4; ++m) { bf16_t* rowp = base + (size_t)(row0 + ai * HALF + m * 16) * ldc + col0;
#pragma unroll
                for (int bj = 0; bj < 2; ++bj) { f32x4 v0 = acc[ai][bj][m][0] * sc, v1 = acc[ai][bj][m][1] * sc;
                    if (sig) { _Pragma("unroll") for (int i_ = 0; i_ < 4; ++i_) { v0[i_] = __builtin_amdgcn_rcpf(1.0f + __builtin_amdgcn_exp2f(-1.4426950408889634f * v0[i_])); v1[i_] = __builtin_amdgcn_rcpf(1.0f + __builtin_amdgcn_exp2f(-1.4426950408889634f * v1[i_])); } }
                    u32x4 w; w.x = cvt_pk_bf16(v0[0], v0[1]); w.y = cvt_pk_bf16(v0[2], v0[3]); w.z = cvt_pk_bf16(v1[0], v1[1]); w.w = cvt_pk_bf16(v1[2], v1[3]);
                    *(u32x4*)(rowp + bj * 8) = w; } }
    }
};
struct EpiFp8 {
    static constexpr bool PERM = true, AFTER_DRAIN = false, WIDE = true, HAS_PRE = false;
    unsigned char* O; int ldc; int nostore = 0;
    __device__ __forceinline__ void operator()(const f32x4 (&acc)[2][2][4][2], const Unit& u, int wr, int wc, int fr, int fq) const {
        const int row0 = u.pm * BM + wr * 64 + fr, col0 = u.pn * BM + wc * 64 + 16 * fq;
#pragma unroll
        for (int ai = 0; ai < 2; ++ai)
#pragma unroll
            for (int m = 0; m < 4; ++m) { unsigned char* rowp = O + (size_t)(row0 + ai * HALF + m * 16) * ldc + col0; u32x4 q;
#pragma unroll
                for (int bj = 0; bj < 2; ++bj) { const f32x4 v0 = acc[ai][bj][m][0], v1 = acc[ai][bj][m][1];
                    const float f8v[8] = {v0[0], v0[1], v0[2], v0[3], v1[0], v1[1], v1[2], v1[3]}; unsigned q0, q1; pack_fp8x8(f8v, q0, q1); if (bj == 0) { q.x = q0; q.y = q1; } else { q.z = q0; q.w = q1; } }
                if (!nostore) *(u32x4*)rowp = q; else asm volatile("" :: "v"(q.x), "v"(q.y), "v"(q.z), "v"(q.w)); }
    }
};
struct EpiResF32 {
    static constexpr bool PERM = false, AFTER_DRAIN = false, WIDE = false, HAS_PRE = false;
    const float* base; float* out; int ldc;
    __device__ __forceinline__ void operator()(const f32x4 (&acc)[2][2][4][2], const Unit& u, int wr, int wc, int fr, int fq) const {
        const int row0 = u.pm * BM + wr * 64 + fr, col0 = u.pn * BM + wc * 32 + 4 * fq;
#pragma unroll
        for (int ai = 0; ai < 2; ++ai)
#pragma unroll
            for (int m = 0; m < 4; ++m) { const size_t off = (size_t)(row0 + ai * HALF + m * 16) * ldc + col0;
#pragma unroll
                for (int bj = 0; bj < 2; ++bj)
#pragma unroll
                    for (int n = 0; n < 2; ++n) { const f32x4 b = *(const f32x4*)(base + off + bj * HALF + n * 16); *(f32x4*)(out + off + bj * HALF + n * 16) = b + acc[ai][bj][m][n]; } }
    }
};
struct EpiResBf16 {
    static constexpr bool PERM = true, AFTER_DRAIN = false, WIDE = true, HAS_PRE = false;
    const bf16_t* base; const float* rms; bf16_t* out; int ldc; unsigned char* out8;
    __device__ __forceinline__ void operator()(const f32x4 (&acc)[2][2][4][2], const Unit& u, int wr, int wc, int fr, int fq) const {
        const int row0 = u.pm * BM + wr * 64 + fr, col0 = u.pn * BM + wc * 64 + 16 * fq;
#pragma unroll
        for (int ai = 0; ai < 2; ++ai)
#pragma unroll
            for (int m = 0; m < 4; ++m) { const size_t off = (size_t)(row0 + ai * HALF + m * 16) * ldc + col0; const float rr = rms[row0 + ai * HALF + m * 16];
                const u32x4 hb0 = *(const u32x4*)(base + off), hb1 = *(const u32x4*)(base + off + 8); u32x4 q;
#pragma unroll
                for (int bj = 0; bj < 2; ++bj) { const u32x4 hb = bj ? hb1 : hb0;
                    const f32x4 b0 = (f32x4){__builtin_bit_cast(float, hb.x << 16), __builtin_bit_cast(float, hb.x & 0xffff0000u), __builtin_bit_cast(float, hb.y << 16), __builtin_bit_cast(float, hb.y & 0xffff0000u)} * rr;
                    const f32x4 b1 = (f32x4){__builtin_bit_cast(float, hb.z << 16), __builtin_bit_cast(float, hb.z & 0xffff0000u), __builtin_bit_cast(float, hb.w << 16), __builtin_bit_cast(float, hb.w & 0xffff0000u)} * rr;
                    const f32x4 v0 = acc[ai][bj][m][0] + b0, v1 = acc[ai][bj][m][1] + b1;
                    u32x4 w; w.x = cvt_pk_bf16(v0[0], v0[1]); w.y = cvt_pk_bf16(v0[2], v0[3]); w.z = cvt_pk_bf16(v1[0], v1[1]); w.w = cvt_pk_bf16(v1[2], v1[3]);
                    *(u32x4*)(out + off + bj * 8) = w;
                    { const float f8v[8] = {v0[0], v0[1], v0[2], v0[3], v1[0], v1[1], v1[2], v1[3]}; unsigned q0, q1; pack_fp8x8(f8v, q0, q1); if (bj == 0) { q.x = q0; q.y = q1; } else { q.z = q0; q.w = q1; } } }
                *(u32x4*)(out8 + off) = q; }
    }
};
struct EpiSwiGLU {
    static constexpr bool PERM = true, AFTER_DRAIN = false, WIDE = false, HAS_PRE = true;
    unsigned char* O; int ldc; const float* rsrow; const PG8_LAS int* off; int cap;
    __device__ __forceinline__ float sg(float g, float up) const { return g * up * __builtin_amdgcn_rcpf(1.0f + __builtin_amdgcn_exp2f(-1.4426950408889634f * g)); }
    __device__ __forceinline__ void prefetch(const Unit& u, int wr, int fr, float (&rs)[2][4]) const {
        const float* rsl = rsrow + (size_t)u.e * cap + (u.pm * BM - off[u.e]) + wr * 64 + fr;
#pragma unroll
        for (int ai = 0; ai < 2; ++ai)
#pragma unroll
            for (int m = 0; m < 4; ++m) rs[ai][m] = rsl[ai * HALF + m * 16];
    }
    __device__ __forceinline__ void operator()(const f32x4 (&acc)[2][2][4][2], const Unit& u, int wr, int wc, int fr, int fq, const float (&rs)[2][4]) const {
        const int row0 = u.pm * BM + wr * 64 + fr;
        unsigned char* colp = O + (size_t)row0 * ldc + u.pn * HALF + wc * 32 + 8 * (fq & ~1);
#pragma unroll
        for (int ai = 0; ai < 2; ++ai)
#pragma unroll
            for (int mp = 0; mp < 2; ++mp) { unsigned qq[2][2];
#pragma unroll
                for (int k = 0; k < 2; ++k) { const int m = 2 * mp + k; const float r = rs[ai][m];
                    const f32x4 g0 = acc[ai][0][m][0] * r, g1 = acc[ai][0][m][1] * r, u0 = acc[ai][1][m][0] * r, u1 = acc[ai][1][m][1] * r;
                    const float hv[8] = {sg(g0[0], u0[0]), sg(g0[1], u0[1]), sg(g0[2], u0[2]), sg(g0[3], u0[3]), sg(g1[0], u1[0]), sg(g1[1], u1[1]), sg(g1[2], u1[2]), sg(g1[3], u1[3])};
                    pack_fp8x8(hv, qq[k][0], qq[k][1]); }
                const auto s0 = __builtin_amdgcn_permlane16_swap(qq[0][0], qq[1][0], false, false), s1 = __builtin_amdgcn_permlane16_swap(qq[0][1], qq[1][1], false, false);
                u32x4 q; q.x = s0[0]; q.y = s1[0]; q.z = s0[1]; q.w = s1[1];
                *(u32x4*)(colp + (size_t)(ai * HALF + (2 * mp + (fq & 1)) * 16) * ldc) = q; }
    }
};

struct NoGather { static constexpr bool ON = false; };
struct RowGather { static constexpr bool ON = true; const int* rowtok; const PG8_LAS int* off; const PG8_LAS int* cnt; int cap;
    __device__ __forceinline__ unsigned rowoff(const Unit& u, int lr, int pitch) const { const int rr = u.pm * BM - off[u.e] + lr, cm = cnt[u.e] - 1; const int tok = rowtok[(size_t)u.e * cap + (rr < cm ? rr : cm)]; return (unsigned)tok * (unsigned)pitch; } };

typedef int v8i32 __attribute__((ext_vector_type(8))); typedef short s16x16 __attribute__((ext_vector_type(16)));
__device__ __forceinline__ v8i32 cat16(bf16x8 lo, bf16x8 hi) { const s16x16 t = __builtin_shufflevector(lo, hi, 0, 1, 2, 3, 4, 5, 6, 7, 8, 9, 10, 11, 12, 13, 14, 15); return __builtin_bit_cast(v8i32, t); }
template <class Epi, class Sched, bool ALIGN_EPI = false, bool SP2 = false, class Gt = NoGather, bool F8 = false>
__device__ __forceinline__ void gemm_phase(PG8_LAS unsigned char* lds, const Gemm g, const Sched& S, const Epi& E, const Gt& GT = Gt()) {
    const int tid = threadIdx.x, wid = __builtin_amdgcn_readfirstlane(tid >> 6), lane = tid & 63, wr = wid >> 2, wc = wid & 3, fr = lane & 15, fq = lane >> 4;
    const int K = g.K, P = F8 ? K : 2 * K  , nt = P / (BK * 2); constexpr int KSTR = 1024;
    unsigned voffA[2], voffB[2];
#pragma unroll
    for (int i = 0; i < 2; ++i) { int R, C; stage_rc(tid * 16 + i * 8192, R, C); const int Rb = Epi::WIDE ? (64 * (R >> 5) + 16 * ((R & 15) >> 2) + 4 * ((R >> 4) & 1) + (R & 3)) : Epi::PERM ? ((R & ~31) + perm32(R & 31)) : R;
        voffA[i] = (unsigned)(R * P + C * 2); voffB[i] = (unsigned)(Rb * P + C * 2); }
    const size_t kstep = (size_t)(BK * 2);
    const size_t hstep = (size_t)HALF * P;
    const size_t bstep = Epi::WIDE ? (size_t)8 * P : hstep;
    const size_t tstep = 2 * hstep;
    const unsigned ldsw = (unsigned)wid * 1024u;
    const int aoff = lds_byte(wr * 64 + fr, fq * 8), boff = lds_byte(wc * 32 + fr, fq * 8);
#define PG8_SA(b, h) (((b) * 2 + (h)) * HTB)
#define PG8_SB(b, h) ((4 + (b) * 2 + (h)) * HTB)
#define PG8_STAGE(bufoff, gbase, voff) do { _Pragma("unroll") for (int _i = 0; _i < 2; ++_i) \
        __builtin_amdgcn_global_load_lds((const unsigned*)((const char*)(gbase) + (voff)[_i]), (PG8_LAS unsigned*)(lds + (bufoff) + ldsw + _i * 8192), 16, 0, 0); } while (0)
#define PG8_STGA(bufoff, gbase, H, NX) do { if constexpr (!Gt::ON) { PG8_STAGE(bufoff, (gbase) + (H) * hstep, voffA); } else { \
        const bool nx_ = (NX); unsigned o_[2]; o_[0] = nx_ ? nOA[H][0] : cOA[H][0]; o_[1] = nx_ ? nOA[H][1] : cOA[H][1]; PG8_STAGE(bufoff, gbase, o_); } } while (0)
#define PG8_GOFF(dst, uu) do { _Pragma("unroll") for (int h_ = 0; h_ < 2; ++h_) _Pragma("unroll") for (int i_ = 0; i_ < 2; ++i_) { int R_, C_; stage_rc(tid * 16 + i_ * 8192, R_, C_); dst[h_][i_] = GT.rowoff(uu, h_ * HALF + R_, P) + (unsigned)C_ * 2u; } } while (0)
#define PG8_LDA(dst, b, h) do { if constexpr (F8) { _Pragma("unroll") for (int m = 0; m < 4; ++m) dst##8[m] = cat16(*(const PG8_LAS bf16x8*)(lds + PG8_SA(b, h) + aoff + m * 2048), *(const PG8_LAS bf16x8*)(lds + PG8_SA(b, h) + aoff + m * 2048 + 1024)); } else { \
        _Pragma("unroll") for (int m = 0; m < 4; ++m) _Pragma("unroll") for (int k = 0; k < 2; ++k) dst[m][k] = *(const PG8_LAS bf16x8*)(lds + PG8_SA(b, h) + aoff + m * 2048 + k * KSTR); } } while (0)
#define PG8_LDB(dst, b, h) do { if constexpr (F8) { _Pragma("unroll") for (int n = 0; n < 2; ++n) dst##8[n] = cat16(*(const PG8_LAS bf16x8*)(lds + PG8_SB(b, h) + boff + n * 2048), *(const PG8_LAS bf16x8*)(lds + PG8_SB(b, h) + boff + n * 2048 + 1024)); } else { \
        _Pragma("unroll") for (int n = 0; n < 2; ++n) _Pragma("unroll") for (int k = 0; k < 2; ++k) dst[n][k] = *(const PG8_LAS bf16x8*)(lds + PG8_SB(b, h) + boff + n * 2048 + k * KSTR); } } while (0)
#define PG8_MMA(ai, bj, At, Bt) do { __builtin_amdgcn_s_setprio(1); if constexpr (F8) { _Pragma("unroll") for (int m = 0; m < 4; ++m) _Pragma("unroll") for (int n = 0; n < 2; ++n) \
        asm volatile("v_mfma_scale_f32_16x16x128_f8f6f4 %0, %1, %2, %0, %3, %4 op_sel_hi:[0,0,0]" : "+v"(acc[ai][bj][m][n]) : "v"(Bt##8[n]), "v"(At##8[m]), "v"(sclW), "v"(sclX)); } else { \
        _Pragma("unroll") for (int m = 0; m < 4; ++m) _Pragma("unroll") for (int n = 0; n < 2; ++n) _Pragma("unroll") for (int k = 0; k < 2; ++k) \
        acc[ai][bj][m][n] = __builtin_amdgcn_mfma_f32_16x16x32_bf16(Bt[n][k], At[m][k], acc[ai][bj][m][n], 0, 0, 0); } __builtin_amdgcn_s_setprio(0); } while (0)
#define PG8_WAIT_V(n) asm volatile("s_waitcnt vmcnt(" #n ")" ::: "memory")
#define PG8_WAIT_L(n) asm volatile("s_waitcnt lgkmcnt(" #n ")" ::: "memory")
#define PG8_BAR __builtin_amdgcn_s_barrier()
#define PG8_SCHED __builtin_amdgcn_sched_barrier(0)
    Unit cur, nxt; int ui = 0;
    if (!S.next(0, cur)) return;
    f32x4 acc[2][2][4][2];
#pragma unroll
    for (int a = 0; a < 2; ++a)
#pragma unroll
        for (int b = 0; b < 2; ++b)
#pragma unroll
            for (int m = 0; m < 4; ++m)
#pragma unroll
                for (int n = 0; n < 2; ++n) acc[a][b][m][n] = (f32x4){0.f, 0.f, 0.f, 0.f};
    int sclW = 123, sclX = 127; asm volatile("" : "+v"(sclW), "+v"(sclX));
    bf16x8 At[4][2], B0[2][2], B1[2][2]; v8i32 At8[4], B08[2], B18[2];
    const char* cA = (const char*)g.A + (Gt::ON ? (size_t)0 : (size_t)cur.pm * tstep); unsigned cOA[2][2] = {{0u, 0u}, {0u, 0u}}, nOA[2][2] = {{0u, 0u}, {0u, 0u}}; if constexpr (Gt::ON) { PG8_GOFF(cOA, cur); } const char* cB = (const char*)g.Bt + (size_t)cur.e * g.bstride + (size_t)cur.pn * tstep;
    S.a_ready(cur);
    if constexpr (SP2) {
        PG8_STAGE(PG8_SB(0, 0), cB, voffB); PG8_STAGE(PG8_SB(0, 1), cB + bstep, voffB); PG8_STGA(PG8_SA(0, 0), cA, 0, false); PG8_STGA(PG8_SA(0, 1), cA, 1, false);
        if (wr == 1) PG8_BAR;
        PG8_WAIT_V(2); PG8_BAR;
        PG8_STAGE(PG8_SB(1, 0), cB + kstep, voffB); PG8_STGA(PG8_SA(1, 0), cA + kstep, 0, false); PG8_STAGE(PG8_SB(1, 1), cB + bstep + kstep, voffB);
        PG8_WAIT_V(6); PG8_BAR;
    } else {
        PG8_STAGE(PG8_SB(0, 0), cB, voffB); PG8_STGA(PG8_SA(0, 0), cA, 0, false); PG8_STAGE(PG8_SB(0, 1), cB + bstep, voffB); PG8_STGA(PG8_SA(0, 1), cA, 1, false);
        if (wr == 1) PG8_BAR;
        PG8_WAIT_V(4); PG8_BAR;
        PG8_STAGE(PG8_SB(1, 0), cB + kstep, voffB); PG8_STGA(PG8_SA(1, 0), cA + kstep, 0, false); PG8_STAGE(PG8_SB(1, 1), cB + bstep + kstep, voffB);
        PG8_WAIT_V(6); PG8_BAR;
    }
    for (;;) {
        float pre[2][4]; if constexpr (Epi::HAS_PRE) E.prefetch(cur, wr, fr, pre);
        const bool has_next = S.next(ui + 1, nxt);
        const char* nA = (has_next && !Gt::ON) ? (const char*)g.A + (size_t)nxt.pm * tstep : cA; if constexpr (Gt::ON) { if (has_next) { PG8_GOFF(nOA, nxt); } else { _Pragma("unroll") for (int h_ = 0; h_ < 2; ++h_) _Pragma("unroll") for (int i_ = 0; i_ < 2; ++i_) nOA[h_][i_] = cOA[h_][i_]; } } const char* nB = has_next ? (const char*)g.Bt + (size_t)nxt.e * g.bstride + (size_t)nxt.pn * tstep : cB;
#pragma nounroll
        for (int t = 0; t < nt; t += 2) {
            const bool last = (t == nt - 2);
            const char* a1 = cA + (size_t)(t + 1) * kstep;
            const char* a2 = last ? nA : cA + (size_t)(t + 2) * kstep; const char* b2 = last ? nB : cB + (size_t)(t + 2) * kstep;
            const char* a3 = a2 + kstep; const char* b3 = b2 + kstep;
            if (last && has_next) S.a_ready(nxt);
            if constexpr (SP2) {
            PG8_LDB(B0, 0, 0); PG8_LDB(B1, 0, 1); PG8_SCHED; PG8_LDA(At, 0, 0); PG8_STGA(PG8_SA(1, 1), a1, 1, false);
            PG8_WAIT_V(8); PG8_WAIT_L(0); PG8_BAR; PG8_MMA(0, 0, At, B0); PG8_MMA(0, 1, At, B1); PG8_BAR; PG8_SCHED;
            PG8_LDA(At, 0, 1); PG8_STAGE(PG8_SB(0, 0), b2, voffB); PG8_STAGE(PG8_SB(0, 1), b2 + bstep, voffB); PG8_STGA(PG8_SA(0, 0), a2, 0, last);
            PG8_WAIT_V(8); PG8_WAIT_L(0); PG8_BAR; PG8_MMA(1, 0, At, B0); PG8_MMA(1, 1, At, B1); PG8_BAR; PG8_SCHED;
            PG8_LDB(B0, 1, 0); PG8_LDB(B1, 1, 1); PG8_SCHED; PG8_LDA(At, 1, 0); PG8_STGA(PG8_SA(0, 1), a2, 1, last);
            PG8_WAIT_V(8); PG8_WAIT_L(0); PG8_BAR; PG8_MMA(0, 0, At, B0); PG8_MMA(0, 1, At, B1); PG8_BAR; PG8_SCHED;
            PG8_LDA(At, 1, 1); PG8_STAGE(PG8_SB(1, 0), b3, voffB); PG8_STAGE(PG8_SB(1, 1), b3 + bstep, voffB); PG8_STGA(PG8_SA(1, 0), a3, 0, last);
            PG8_WAIT_V(8); PG8_WAIT_L(0); PG8_BAR; PG8_MMA(1, 0, At, B0); PG8_MMA(1, 1, At, B1); PG8_BAR; PG8_SCHED;
            } else {
            PG8_LDB(B0, 0, 0); PG8_SCHED; PG8_LDA(At, 0, 0); PG8_STGA(PG8_SA(1, 1), a1, 1, false);
            PG8_WAIT_L(8); PG8_BAR; PG8_WAIT_L(0); PG8_MMA(0, 0, At, B0); PG8_BAR; PG8_SCHED;
            PG8_LDB(B1, 0, 1); PG8_STAGE(PG8_SB(0, 0), b2, voffB);
            PG8_BAR; PG8_WAIT_L(0); PG8_MMA(0, 1, At, B1); PG8_BAR;
            PG8_LDA(At, 0, 1); PG8_STGA(PG8_SA(0, 0), a2, 0, last);
            PG8_BAR; PG8_WAIT_L(0); PG8_MMA(1, 0, At, B0); PG8_BAR; PG8_SCHED;
            PG8_STAGE(PG8_SB(0, 1), b2 + bstep, voffB);
            PG8_WAIT_V(6); PG8_BAR; PG8_MMA(1, 1, At, B1); PG8_BAR;
            PG8_LDB(B0, 1, 0); PG8_SCHED; PG8_LDA(At, 1, 0); PG8_STGA(PG8_SA(0, 1), a2, 1, last);
            PG8_WAIT_L(8); PG8_BAR; PG8_WAIT_L(0); PG8_MMA(0, 0, At, B0); PG8_BAR; PG8_SCHED;
            PG8_LDB(B1, 1, 1); PG8_STAGE(PG8_SB(1, 0), b3, voffB);
            PG8_BAR; PG8_WAIT_L(0); PG8_MMA(0, 1, At, B1); PG8_BAR;
            PG8_LDA(At, 1, 1); PG8_STGA(PG8_SA(1, 0), a3, 0, last);
            PG8_BAR; PG8_WAIT_L(0); PG8_MMA(1, 0, At, B0); PG8_BAR; PG8_SCHED;
            PG8_STAGE(PG8_SB(1, 1), b3 + bstep, voffB);
            PG8_WAIT_V(6); PG8_BAR; PG8_MMA(1, 1, At, B1); PG8_BAR;
            }
        }
        if constexpr (F8) asm volatile("s_nop 15\n\ts_nop 15" : "+v"(acc[1][1][0][0]), "+v"(acc[1][1][0][1]), "+v"(acc[1][1][1][0]), "+v"(acc[1][1][1][1]), "+v"(acc[1][1][2][0]), "+v"(acc[1][1][2][1]), "+v"(acc[1][1][3][0]), "+v"(acc[1][1][3][1]));
        if constexpr (ALIGN_EPI) { if (wr == 0) PG8_BAR; }
        if constexpr (!Epi::AFTER_DRAIN) { if constexpr (Epi::HAS_PRE) E(acc, cur, wr, wc, fr, fq, pre); else E(acc, cur, wr, wc, fr, fq); S.done(cur); }
        if (!has_next) break;
#pragma unroll
        for (int a = 0; a < 2; ++a)
#pragma unroll
            for (int b = 0; b < 2; ++b)
#pragma unroll
                for (int m = 0; m < 4; ++m)
#pragma unroll
                    for (int n = 0; n < 2; ++n) acc[a][b][m][n] = (f32x4){0.f, 0.f, 0.f, 0.f};
        cur = nxt; cA = nA; cB = nB; ++ui; if constexpr (Gt::ON) { _Pragma("unroll") for (int h_ = 0; h_ < 2; ++h_) _Pragma("unroll") for (int i_ = 0; i_ < 2; ++i_) cOA[h_][i_] = nOA[h_][i_]; }
        if constexpr (ALIGN_EPI) { if (wr == 1) PG8_BAR; }
    }
    PG8_WAIT_V(0);
    if constexpr (!ALIGN_EPI) { if (wr == 0) PG8_BAR; }
    PG8_BAR;
    if constexpr (Epi::AFTER_DRAIN) { E.fused(acc, cur, wr, wc, fr, fq, lds, wid, lane); S.done(cur); }
#undef PG8_SA
#undef PG8_SB
#undef PG8_STAGE
#undef PG8_LDA
#undef PG8_STGA
#undef PG8_GOFF
#undef PG8_LDB
#undef PG8_MMA
#undef PG8_WAIT_V
#undef PG8_WAIT_L
#undef PG8_BAR
#undef PG8_SCHED
}
}


#define PG8_SP2 true
#define PG8_ALIGN true

#include <hip/hip_bf16.h>
#include <cmath>
namespace attn_body {
using bf16=__hip_bfloat16;
using bf16x8=__attribute__((ext_vector_type(8)))short;
using s16x4=__attribute__((ext_vector_type(4)))short;
using f32x16=__attribute__((ext_vector_type(16)))float;
using u32x4=__attribute__((ext_vector_type(4)))unsigned;
constexpr int BATCH=8,NHC=8,SEQ=4096,D=64,DV=128,PQ=512,PO=1024;
constexpr int NW=8,QBLK=32,QB=QBLK*NW,KVBLK=64,NQB=SEQ/QB;
constexpr int ATTN_UNIT_ROWS=QB;
__device__ __forceinline__ int crow(int r,int hi){return (r&3)+8*(r>>2)+4*hi;}
#define SBAR() __builtin_amdgcn_sched_barrier(0)
__device__ __forceinline__ void cmask(f32x16&p0,f32x16&p1,int jb,int qrel,int hi,const __attribute__((address_space(3))) float*dl){
  const __attribute__((address_space(3))) float*e=dl+(256+qrel-64*(jb-2)-4*hi);
  #pragma unroll
  for(int r=0;r<16;++r){const int o=(r&3)+8*(r>>2); p0[r]=__builtin_fminf(p0[r],16384.f)+e[-o]; p1[r]=__builtin_fminf(p1[r],16384.f)+e[-o-32];}
}
constexpr int NSLOT=3, SLOTB=8192;
constexpr int LDS_K=0, LDS_V=NSLOT*SLOTB, LDS_WS=LDS_V+NSLOT*2*SLOTB, LDS_OST=LDS_WS+NW*64*4, LDS_QS=LDS_OST+NW*4096, LDS_BYTES=LDS_QS+NW*4096;
constexpr float C2=0.125f*1.4426950408889634f;
__device__ __forceinline__ void glds16(const void*gsrc,unsigned lds_dst){unsigned keep;
  asm volatile("s_mov_b32 %0, m0\n\ts_mov_b32 m0, %2\n\ts_nop 0\n\tglobal_load_lds_dwordx4 %1, off\n\ts_mov_b32 m0, %0":"=&s"(keep):"v"(gsrc),"s"(lds_dst):"memory");}
__device__ __forceinline__ float max3f(float a,float b,float c){float r;asm("v_max3_f32 %0, %1, %2, %3":"=v"(r):"v"(a),"v"(b),"v"(c));return r;}
__device__ __forceinline__ float max2f(float a,float b){float r;asm("v_max_f32_e32 %0, %1, %2":"=v"(r):"v"(a),"v"(b));return r;}
__device__ __forceinline__ float fadd_s(float a,float b){float r;asm("v_add_f32_e32 %0, %1, %2":"=v"(r):"v"(a),"v"(b));return r;}
__device__ __forceinline__ float fsub_s(float a,float b){float r;asm("v_sub_f32_e32 %0, %1, %2":"=v"(r):"v"(a),"v"(b));return r;}
typedef float f32x2_t __attribute__((ext_vector_type(2))); typedef __bf16 bf16x2_t __attribute__((ext_vector_type(2)));
__device__ __forceinline__ unsigned cvtpk_s(float lo,float hi){f32x2_t v={lo,hi};bf16x2_t b=__builtin_convertvector(v,bf16x2_t);return __builtin_bit_cast(unsigned,b);}
#define WAIT_BAR(N) asm volatile("s_waitcnt vmcnt(" #N ") lgkmcnt(0)\n\ts_barrier":::"memory")

__device__ __forceinline__ void qkt(f32x16&p0,f32x16&p1,const char*Kslot,const bf16x8*qr,const f32x16&negm,int r32,int hi){
  const char*kb=Kslot+hi*1024+r32*16;
  #pragma unroll
  for(int d0=0;d0<4;++d0){
    const bf16x8 b0=*reinterpret_cast<const bf16x8*>(kb+d0*2048);
    const bf16x8 b1=*reinterpret_cast<const bf16x8*>(kb+d0*2048+512);
    if(d0==0){p0=__builtin_amdgcn_mfma_f32_32x32x16_bf16(b0,qr[0],negm,0,0,0);p1=__builtin_amdgcn_mfma_f32_32x32x16_bf16(b1,qr[0],negm,0,0,0);}
    else{p0=__builtin_amdgcn_mfma_f32_32x32x16_bf16(b0,qr[d0],p0,0,0,0);p1=__builtin_amdgcn_mfma_f32_32x32x16_bf16(b1,qr[d0],p1,0,0,0);}}
}
typedef __attribute__((address_space(3))) const char* lds_cptr;
typedef short v4i16_t __attribute__((ext_vector_type(4)));
__device__ __forceinline__ void kload8(bf16x8*kf,lds_cptr kp){
  kf[0]=*(const __attribute__((address_space(3))) bf16x8*)(kp);      kf[1]=*(const __attribute__((address_space(3))) bf16x8*)(kp+512);
  kf[2]=*(const __attribute__((address_space(3))) bf16x8*)(kp+2048); kf[3]=*(const __attribute__((address_space(3))) bf16x8*)(kp+2560);
  kf[4]=*(const __attribute__((address_space(3))) bf16x8*)(kp+4096); kf[5]=*(const __attribute__((address_space(3))) bf16x8*)(kp+4608);
  kf[6]=*(const __attribute__((address_space(3))) bf16x8*)(kp+6144); kf[7]=*(const __attribute__((address_space(3))) bf16x8*)(kp+6656);
}
__device__ __forceinline__ void kload2(bf16x8*kf,lds_cptr kp,int j){ kf[2*j]=*(const __attribute__((address_space(3))) bf16x8*)(kp+j*2048); kf[2*j+1]=*(const __attribute__((address_space(3))) bf16x8*)(kp+j*2048+512); }
__device__ __forceinline__ s16x4 vtr(lds_cptr p){ return __builtin_bit_cast(s16x4,__builtin_amdgcn_ds_read_tr16_b64_v4i16((__attribute__((address_space(3))) v4i16_t*)p)); }
__device__ __forceinline__ float rowmax(const f32x16&p0,const f32x16&p1){
  float a=max3f(p0[0],p0[1],p1[0]),b=max3f(p0[2],p0[3],p1[1]);a=max3f(a,p1[2],p1[3]);
  #pragma unroll
  for(int r=4;r<16;r+=4){a=max3f(a,p0[r],p0[r+1]);b=max3f(b,p0[r+2],p0[r+3]);a=max3f(a,p1[r],p1[r+1]);b=max3f(b,p1[r+2],p1[r+3]);}
  const float m=max2f(a,b);
  auto rr=__builtin_amdgcn_permlane32_swap(__float_as_uint(m),__float_as_uint(m),false,false);
  return max2f(__uint_as_float(rr[0]),__uint_as_float(rr[1]));
}
__device__ __forceinline__ void pv(f32x16*o,int vb,bf16x8 pa0,bf16x8 pa1,bf16x8 pa2,bf16x8 pa3){
  #pragma unroll
  for(int d0=0;d0<4;++d0){s16x4 lo[4],hi[4];
    #pragma unroll
    for(int ks=0;ks<4;++ks){
      asm volatile("ds_read_b64_tr_b16 %0,%1 offset:%c2":"=&v"(lo[ks]):"v"(vb),"i"(d0*4096+ks*1024):"memory");
      asm volatile("ds_read_b64_tr_b16 %0,%1 offset:%c2":"=&v"(hi[ks]):"v"(vb),"i"(d0*4096+ks*1024+512):"memory");}
    asm volatile("s_waitcnt lgkmcnt(0)":::"memory");SBAR();
    #define PK(k) (bf16x8){lo[k][0],lo[k][1],lo[k][2],lo[k][3],hi[k][0],hi[k][1],hi[k][2],hi[k][3]}
    o[d0]=__builtin_amdgcn_mfma_f32_32x32x16_bf16(pa0,PK(0),o[d0],0,0,0);
    o[d0]=__builtin_amdgcn_mfma_f32_32x32x16_bf16(pa1,PK(1),o[d0],0,0,0);
    o[d0]=__builtin_amdgcn_mfma_f32_32x32x16_bf16(pa2,PK(2),o[d0],0,0,0);
    o[d0]=__builtin_amdgcn_mfma_f32_32x32x16_bf16(pa3,PK(3),o[d0],0,0,0);
    #undef PK
  }
}

#ifndef ATTN_STORE16
#define ATTN_STORE16(p,v) (*(u32x4*)(p)=(v))
#endif
template<int THRL> __device__ __forceinline__ void attn_unit(int b,int hc,int qb,const bf16*Q,const bf16*__restrict__ K,const bf16*__restrict__ V,bf16*O,char*shm,const __attribute__((address_space(3))) float*dltab){
  int zl_=0; asm volatile("":"+v"(zl_));
  const int tid=(int)threadIdx.x+zl_,lane=tid&63,r32=lane&31,hi=lane>>5; const int wid=__builtin_amdgcn_readfirstlane(tid>>6);
  const long rowbase=(long)b*SEQ; const int q0=qb*QB;
  const int qcol=hc*D, vcol=(hc>>1)*DV, ocol=(hc&1)*512+(hc>>1)*DV;
  const __attribute__((address_space(3))) float*dl=dltab+(hc>>1)*640;
  const bf16*Qw=Q+(rowbase+q0+wid*QBLK)*PQ+qcol;
  const bf16*Kh=K+rowbase*PQ+qcol,*Vh=V+rowbase*PQ+vcol;
  const unsigned lds0=(unsigned)(uintptr_t)shm;
  float*wsf=(float*)(shm+LDS_WS)+wid*64;
  const bf16*ksrc=Kh+(long)lane*PQ+wid*8;
  const bf16*vsrc=Vh+(long)(16*(wid&3)+(lane>>2))*PQ+(wid>>2)*32+(lane&3)*8;
  const unsigned kdst=lds0+LDS_K+wid*1024, vdst=lds0+LDS_V+wid*1024;
  #define DMA_K(t,slot) glds16(ksrc+(long)(t)*KVBLK*PQ,(unsigned)__builtin_amdgcn_readfirstlane(kdst+(slot)))
  #define DMA_V(t,slot) do{ glds16(vsrc+(long)(t)*KVBLK*PQ,(unsigned)__builtin_amdgcn_readfirstlane(vdst+2*(slot))); glds16(vsrc+64+(long)(t)*KVBLK*PQ,(unsigned)__builtin_amdgcn_readfirstlane(vdst+2*(slot)+8192)); }while(0)
  const int vb0=(int)(lds0+LDS_V)+((lane>>4)&1)*32+(lane&3)*8+(4*hi+((lane&15)>>2))*64;
  const char*Kbase=shm+LDS_K; bf16x8 kf[8];
  const lds_cptr shm3=(lds_cptr)shm; const lds_cptr kp0=shm3+LDS_K+hi*1024+r32*16; const lds_cptr vp0=shm3+LDS_V+((lane>>4)&1)*32+(lane&3)*8+(4*hi+((lane&15)>>2))*64;
  const int NT=(q0+QB)/KVBLK;
  DMA_K(0,0);DMA_V(0,0);DMA_K(1,SLOTB);
  bf16x8 qr[4];
  #pragma unroll
  for(int d0=0;d0<4;++d0)qr[d0]=*reinterpret_cast<const bf16x8*>(&Qw[(long)r32*PQ+d0*16+hi*8]);
  const lds_cptr qp=(lds_cptr)shm+LDS_QS+wid*4096+lane*16;
  float mhat=0.f,l_reg=0.f;f32x16 o[4];o[0]=f32x16{};o[1]=f32x16{};o[2]=f32x16{};o[3]=f32x16{};f32x16 negm=f32x16{};asm volatile("":"+v"(negm));
  const int qrel=wid*QBLK+r32;
  #define CMASK(P0,P1,t) do{int jb_=(t)-(NT-6); if(jb_>=0)cmask(P0,P1,jb_,qrel,hi,dl);}while(0)
  bool resc=false;
  #define START(P0,P1) do{ const float rm=rowmax(P0,P1); resc=false; \
    { const float dl=rm; mhat=fadd_s(mhat,dl); \
      _Pragma("unroll") for(int r=0;r<16;++r){P0[r]=fsub_s(P0[r],dl);P1[r]=fsub_s(P1[r],dl);} \
      _Pragma("unroll") for(int r=0;r<16;++r)negm[r]=-mhat; asm volatile("":"+v"(negm)); } \
    _Pragma("unroll") for(int r=0;r<16;++r)P0[r]=__builtin_amdgcn_exp2f(P0[r]); }while(0)
  #define RESC() do{ if(resc){ asm volatile("s_waitcnt lgkmcnt(0)":::"memory"); \
      _Pragma("unroll") for(int d_=0;d_<4;++d_) _Pragma("unroll") for(int r=0;r<16;++r)o[d_][r]*=wsf[crow(r,hi)]; } }while(0)
  f32x16 pA0,pA1,pB0,pB1;
  int sl_prev=0,sl_cur=0,sl_next=SLOTB;
  #define ROT() do{sl_prev=sl_cur;sl_cur=sl_next;sl_next=(sl_next==(NSLOT-1)*SLOTB)?0:sl_next+SLOTB;}while(0)
  DMA_K(2,2*SLOTB);
  WAIT_BAR(4);
  qkt(pA0,pA1,Kbase,qr,negm,r32,hi);asm volatile("s_nop 15\n\ts_nop 7":"+v"(pA0),"+v"(pA1));CMASK(pA0,pA1,0);
  START(pA0,pA1);
  _Pragma("unroll") for(int d0=0;d0<4;++d0)*(__attribute__((address_space(3))) bf16x8*)(qp+d0*1024)=qr[d0];
  _Pragma("unroll") for(int r=0;r<16;++r)pA1[r]=__builtin_amdgcn_exp2f(pA1[r]);
  WAIT_BAR(0);
  DMA_K(3,0);DMA_V(1,SLOTB);
  ROT();
  kload8(kf,kp0+sl_cur);
  WAIT_BAR(3);
  s16x4 vlo[8],vhi[8]; u32x4 pw0,pw1,pw2,pw3;
  #define PKW(P,B) cvtpk_s(P[B],P[B+1])
  #define PAF(k) __builtin_bit_cast(bf16x8,pw##k)
  #define VFR(i) (bf16x8){vlo[i][0],vlo[i][1],vlo[i][2],vlo[i][3],vhi[i][0],vhi[i][1],vhi[i][2],vhi[i][3]}
  #define PIN(x) asm volatile("":"+v"(x))
  #define MX3(a,b,c) __builtin_fmaxf(__builtin_fmaxf((a),(b)),(c))
  #define GAPA(MF,A0,A1,A2,A3,W0,W1,PW) do{ MF; sacc+=A0; sacc+=A1; sacc+=A2; sacc+=A3; PIN(sacc); W0; W1; PIN(PW); SBAR(); }while(0)
  #define EX(v) __builtin_amdgcn_exp2f(v)
  #define GAPB1(MF,i,X,B) do{ MF; VRD2(i); X[B]=EX(X[B]); X[B+1]=EX(X[B+1]); PIN(X); SBAR(); }while(0)
  #define GAPB2(MF,X,B) do{ MF; X[B]=EX(X[B]); X[B+1]=EX(X[B+1]); PIN(X); SBAR(); }while(0)
  #define VRD(i) do{ vlo[i]=vtr(vp_+(((i)>>2)*4096+((i)&3)*1024)); vhi[i]=vtr(vp_+(((i)>>2)*4096+((i)&3)*1024+512)); }while(0)
  #define VRD2(i) do{ vlo[i]=vtr(vp_+(8192+((i)>>2)*4096+((i)&3)*1024)); vhi[i]=vtr(vp_+(8192+((i)>>2)*4096+((i)&3)*1024+512)); }while(0)
  #define QLD(d0) ((d0)<2 ? qr[d0] : *(const __attribute__((address_space(3))) bf16x8*)(qp+(d0)*1024))
  #define KRD(G,j) do{ if(G){ kload2(kf,kp0+sl_next,j); SBAR(); } }while(0)
  #define STEP(C0,C1,P0,P1,t,GK,GV,GL) do{ SBAR(); \
    const lds_cptr vp_=vp0+2*sl_prev; \
    bf16x8 qf=QLD(0); VRD(0); SBAR(); float sacc=(P0[0]+P0[1]); \
    GAPA(C0=__builtin_amdgcn_mfma_f32_32x32x16_bf16(kf[0],qf,negm,0,0,0), P0[2],P0[3],P0[4],P0[5],     pw0[0]=PKW(P0,0), pw0[1]=PKW(P0,2), pw0); \
    VRD(4); SBAR(); GAPA(C1=__builtin_amdgcn_mfma_f32_32x32x16_bf16(kf[1],qf,negm,0,0,0), P0[6],P0[7],P0[8],P0[9],     pw0[2]=PKW(P0,4), pw0[3]=PKW(P0,6), pw0); \
    qf=QLD(1); VRD(1); SBAR(); GAPA(C0=__builtin_amdgcn_mfma_f32_32x32x16_bf16(kf[2],qf,C0,0,0,0),   P0[10],P0[11],P0[12],P0[13], pw1[0]=PKW(P0,8), pw1[1]=PKW(P0,10), pw1); \
    VRD(5); SBAR(); GAPA(C1=__builtin_amdgcn_mfma_f32_32x32x16_bf16(kf[3],qf,C1,0,0,0),   P0[14],P0[15],P1[0],P1[1],   pw1[2]=PKW(P0,12),pw1[3]=PKW(P0,14), pw1); \
    qf=QLD(2); VRD(2); SBAR(); GAPA(C0=__builtin_amdgcn_mfma_f32_32x32x16_bf16(kf[4],qf,C0,0,0,0),   P1[2],P1[3],P1[4],P1[5],     pw2[0]=PKW(P1,0), pw2[1]=PKW(P1,2), pw2); \
    VRD(6); SBAR(); GAPA(C1=__builtin_amdgcn_mfma_f32_32x32x16_bf16(kf[5],qf,C1,0,0,0),   P1[6],P1[7],P1[8],P1[9],     pw2[2]=PKW(P1,4), pw2[3]=PKW(P1,6), pw2); \
    qf=QLD(3); VRD(3); SBAR(); GAPA(C0=__builtin_amdgcn_mfma_f32_32x32x16_bf16(kf[6],qf,C0,0,0,0),   P1[10],P1[11],P1[12],P1[13], pw3[0]=PKW(P1,8), pw3[1]=PKW(P1,10), pw3); \
    VRD(7); SBAR(); GAPA(C1=__builtin_amdgcn_mfma_f32_32x32x16_bf16(kf[7],qf,C1,0,0,0),   P1[14],P1[15],0.f,0.f,       pw3[2]=PKW(P1,12),pw3[3]=PKW(P1,14), pw3); \
    l_reg+=sacc; \
    if(GK){DMA_K((t)+3,sl_cur);} if(GV){DMA_V((t)+1,sl_next);} \
    CMASK(C0,C1,t); \
    { float a=MX3(C0[0],C0[1],C1[0]),b=MX3(C0[2],C0[3],C1[1]); a=MX3(a,C1[2],C1[3]); \
      _Pragma("unroll") for(int r=4;r<16;r+=4){a=MX3(a,C0[r],C0[r+1]);b=MX3(b,C0[r+2],C0[r+3]);a=MX3(a,C1[r],C1[r+1]);b=MX3(b,C1[r+2],C1[r+3]);} \
      float rm=__builtin_fmaxf(a,b); { auto rr=__builtin_amdgcn_permlane32_swap(__float_as_uint(rm),__float_as_uint(rm),false,false); rm=__builtin_fmaxf(__uint_as_float(rr[0]),__uint_as_float(rr[1])); } \
      resc=false; \
      if(__builtin_expect(__any(rm>(float)THRL),0)){ const float dl=__builtin_fmaxf(rm,0.f); mhat+=dl; \
        _Pragma("unroll") for(int r=0;r<16;++r){C0[r]-=dl;C1[r]-=dl;} \
        _Pragma("unroll") for(int r=0;r<16;++r)negm[r]=-mhat; asm volatile("":"+v"(negm)); \
        const float f=__builtin_amdgcn_exp2f(-dl); l_reg*=f; if(hi==0)wsf[r32]=f; resc=true; } } \
    SBAR(); \
    GAPB1(o[0]=__builtin_amdgcn_mfma_f32_32x32x16_bf16(PAF(0),VFR(0),o[0],0,0,0), 0, C0,0); \
    GAPB1(o[1]=__builtin_amdgcn_mfma_f32_32x32x16_bf16(PAF(0),VFR(4),o[1],0,0,0), 4, C0,2); \
    GAPB1(o[0]=__builtin_amdgcn_mfma_f32_32x32x16_bf16(PAF(1),VFR(1),o[0],0,0,0), 1, C0,4); \
    GAPB1(o[1]=__builtin_amdgcn_mfma_f32_32x32x16_bf16(PAF(1),VFR(5),o[1],0,0,0), 5, C0,6); \
    GAPB1(o[0]=__builtin_amdgcn_mfma_f32_32x32x16_bf16(PAF(2),VFR(2),o[0],0,0,0), 2, C0,8); \
    GAPB1(o[1]=__builtin_amdgcn_mfma_f32_32x32x16_bf16(PAF(2),VFR(6),o[1],0,0,0), 6, C0,10); \
    GAPB1(o[0]=__builtin_amdgcn_mfma_f32_32x32x16_bf16(PAF(3),VFR(3),o[0],0,0,0), 3, C0,12); \
    GAPB1(o[1]=__builtin_amdgcn_mfma_f32_32x32x16_bf16(PAF(3),VFR(7),o[1],0,0,0), 7, C0,14); \
    GAPB2(o[2]=__builtin_amdgcn_mfma_f32_32x32x16_bf16(PAF(0),VFR(0),o[2],0,0,0), C1,0); \
    GAPB2(o[3]=__builtin_amdgcn_mfma_f32_32x32x16_bf16(PAF(0),VFR(4),o[3],0,0,0), C1,2); \
    KRD(GL,0); GAPB2(o[2]=__builtin_amdgcn_mfma_f32_32x32x16_bf16(PAF(1),VFR(1),o[2],0,0,0), C1,4); \
    KRD(GL,1); GAPB2(o[3]=__builtin_amdgcn_mfma_f32_32x32x16_bf16(PAF(1),VFR(5),o[3],0,0,0), C1,6); \
    KRD(GL,2); GAPB2(o[2]=__builtin_amdgcn_mfma_f32_32x32x16_bf16(PAF(2),VFR(2),o[2],0,0,0), C1,8); \
    KRD(GL,3); GAPB2(o[3]=__builtin_amdgcn_mfma_f32_32x32x16_bf16(PAF(2),VFR(6),o[3],0,0,0), C1,10); \
    GAPB2(o[2]=__builtin_amdgcn_mfma_f32_32x32x16_bf16(PAF(3),VFR(3),o[2],0,0,0), C1,12); \
    GAPB2(o[3]=__builtin_amdgcn_mfma_f32_32x32x16_bf16(PAF(3),VFR(7),o[3],0,0,0), C1,14); \
    }while(0)
  int t=1;
  if(wid>=4)__builtin_amdgcn_s_setprio(1);
  #undef CMASK
  #define CMASK(P0,P1,t) do{}while(0)
  for(;t+7<NT;t+=2){
    STEP(pB0,pB1,pA0,pA1,t,true,true,true);     WAIT_BAR(3); RESC(); ROT();
    STEP(pA0,pA1,pB0,pB1,t+1,true,true,true);   WAIT_BAR(3); RESC(); ROT();
  }
  #undef CMASK
  #define CMASK(P0,P1,t) do{int jb_=(t)-(NT-6); if(jb_>=0)cmask(P0,P1,jb_,qrel,hi,dl);}while(0)
  #define ENDW(tt) do{ if((tt)+3<NT){WAIT_BAR(3);} else if((tt)+2<NT){WAIT_BAR(2);} else {WAIT_BAR(0);} }while(0)
  for(;t+1<NT;t+=2){
    STEP(pB0,pB1,pA0,pA1,t,(t+3<NT),(t+1<NT),(t+1<NT));       ENDW(t);   RESC(); ROT();
    STEP(pA0,pA1,pB0,pB1,t+1,(t+4<NT),(t+2<NT),(t+2<NT));     ENDW(t+1); RESC(); ROT();
  }
  STEP(pB0,pB1,pA0,pA1,NT-1,false,false,false); RESC(); __builtin_amdgcn_s_setprio(0);
  { float sacc=pB0[0]+pB0[1]; _Pragma("unroll") for(int r=2;r<16;++r)sacc+=pB0[r]; _Pragma("unroll") for(int r=0;r<16;++r)sacc+=pB1[r]; l_reg+=sacc;
    pw0=(u32x4){PKW(pB0,0),PKW(pB0,2),PKW(pB0,4),PKW(pB0,6)};pw1=(u32x4){PKW(pB0,8),PKW(pB0,10),PKW(pB0,12),PKW(pB0,14)};pw2=(u32x4){PKW(pB1,0),PKW(pB1,2),PKW(pB1,4),PKW(pB1,6)};pw3=(u32x4){PKW(pB1,8),PKW(pB1,10),PKW(pB1,12),PKW(pB1,14)};
    SBAR(); pv(o,vb0+2*sl_cur,PAF(0),PAF(1),PAF(2),PAF(3)); }
  #undef PKW
  #undef PAF
  #undef VFR
  #undef PIN
  #undef MX3
  #undef GAPA
  #undef GAPB1
  #undef GAPB2
  #undef VRD2
  #undef EX
  #undef VRD
  #undef KRD
  #undef QLD
  #undef STEP
  #undef ENDW
  {auto rr=__builtin_amdgcn_permlane32_swap(__float_as_uint(l_reg),__float_as_uint(l_reg),false,false);l_reg=__uint_as_float(rr[0])+__uint_as_float(rr[1]);}
  if(hi==0)wsf[32+r32]=l_reg;asm volatile("s_waitcnt lgkmcnt(0)":::"memory");
  float rli[16];
  #pragma unroll
  for(int r=0;r<16;++r)rli[r]=__builtin_amdgcn_rcpf(wsf[32+crow(r,hi)]);
  bf16*Ow=O+(rowbase+q0+wid*QBLK)*PO+ocol;
  { bf16*stg=(bf16*)(shm+LDS_OST)+wid*2048;
    #pragma unroll
    for(int hp=0;hp<2;++hp){
      #pragma unroll
      for(int r=0;r<16;++r){const int orow=crow(r,hi);
        #pragma unroll
        for(int d0=0;d0<2;++d0)stg[orow*64+d0*32+r32]=__float2bfloat16(o[2*hp+d0][r]*rli[r]);}
      asm volatile("s_waitcnt lgkmcnt(0)":::"memory");
      #pragma unroll
      for(int i=0;i<4;++i){const int row=i*8+(lane>>3),ch=lane&7; const u32x4 v=*(const u32x4*)(stg+row*64+ch*8); ATTN_STORE16(Ow+(long)row*PO+hp*64+ch*8,v);}
      asm volatile("s_waitcnt lgkmcnt(0)":::"memory");
    } }
  asm volatile("s_waitcnt lgkmcnt(0)\n\ts_barrier":::"memory");
  #undef DMA_K
  #undef DMA_V
  #undef CMASK
  #undef START
  #undef RESC
  #undef ROT
}
constexpr int ATTN_LDS_BYTES=LDS_BYTES;
struct AttnTensors { const bf16* Q; const bf16* K; const bf16* V; bf16* O; };
struct AttnUnit { int b; int hc; int qb; };
struct StaticOrder {
  int vcu;
  __device__ __forceinline__ explicit StaticOrder(int grid,int block):vcu((block%8)*(grid/8)+block/8){}
  __device__ __forceinline__ bool next(int i,AttnUnit&u)const{ if(i>=4||vcu>=256)return false; const int s=vcu&3,pr=vcu>>2; u.b=pr>>3; u.hc=pr&7; u.qb=(i==0)?15-s:(i==1)?8+s:(i==2)?7-s:s; return true; }
  __device__ __forceinline__ void a_ready(const AttnUnit&)const{}
  __device__ __forceinline__ void done(const AttnUnit&)const{}
};
template<class Sched,int THRL=8> __device__ __forceinline__ void attn_phase(char*lds,const AttnTensors&T,const Sched&S,const __attribute__((address_space(3))) float*dltab){
  AttnUnit u;
  for(int i=0;S.next(i,u);++i){ S.a_ready(u); attn_unit<THRL>(u.b,u.hc,u.qb,T.Q,T.K,T.V,T.O,lds,dltab); S.done(u); }
}
#undef SBAR
#undef WAIT_BAR
}

constexpr int NWAVES = 8;
#ifndef MK_PER_PHASE
#define MK_PER_PHASE 0
#endif
constexpr int BATCH = 8, SEQ = 4096, D = 1024, M = BATCH * SEQ;
constexpr int NPROJ = 3072, DH = 512, NH = 4, HD = 128, CHUNK = 128, NCH = SEQ / CHUNK, NU3 = BATCH * NH * NCH;
constexpr int NEXP = 32, FFE = 512, MAXT = 288;
constexpr float EPS_RMS = 1e-6f, EPS_SUB = 1e-5f, LAM_INIT = 0.2f, KSCALE = 0.08838834764831845f  ;
constexpr float LOG2E = 1.4426950408889634f;

constexpr size_t MiB = 1u << 20, KiB = 1024;
constexpr size_t WS_CTL = 0, CTL_ZERO_BYTES = 20480;
constexpr size_t WS_WIN = 2 * MiB, WS_WOUT = 8 * MiB, WS_WQ = 10 * MiB, WS_WK = 10 * MiB + 128 * KiB, WS_WG = 10 * MiB + 256 * KiB, WS_WR = 10 * MiB + 320 * KiB, WS_WC = 10 * MiB + 448 * KiB;
constexpr size_t WS_WGU = 12 * MiB, WS_WD = 76 * MiB;
constexpr size_t WS_HB = 108 * MiB;
constexpr size_t OUT_A2 = 64 * MiB;
constexpr size_t WS_PC = 172 * MiB, WS_PV = 204 * MiB, WS_PZ = 236 * MiB, WS_PQ = 268 * MiB, WS_PK = 300 * MiB, WS_PVD = 332 * MiB;
constexpr size_t WS_CP = WS_PC;
constexpr size_t WS_MQ = 364 * MiB, WS_MK = 396 * MiB, WS_CA = 428 * MiB;
constexpr size_t WS_X1B = 396 * MiB;
constexpr size_t WS_XP = 172 * MiB;
constexpr size_t WS_Y = WS_XP;
constexpr size_t WS_HID = 316 * MiB;
constexpr size_t WS_X1F8 = 352 * MiB;
constexpr size_t WS_SM = 460 * MiB;
constexpr size_t SM_GI = WS_SM, SM_GF = WS_SM + 512 * KiB, SM_GB = WS_SM + 1024 * KiB, SM_GMAX = WS_SM + 1536 * KiB, SM_BEND = WS_SM + 1540 * KiB, SM_MPREV = WS_SM + 1544 * KiB;
constexpr size_t SM_DN = WS_SM + 1552 * KiB, SM_NP = WS_SM + 2064 * KiB, SM_EID = WS_SM + 2576 * KiB, SM_GATE = WS_SM + 2832 * KiB, SM_POS = WS_SM + 3088 * KiB, SM_ROWTOK = WS_SM + 3344 * KiB, SM_RMS1 = SM_ROWTOK;
constexpr size_t WS_RT = 464 * MiB; constexpr int RT_CAP = 65536;
constexpr size_t WS_RS = 472 * MiB;
constexpr size_t WS_END = 480 * MiB;
static_assert(WS_HID + (size_t)MAXT * 256 * FFE * 2 <= WS_SM && WS_XP + (size_t)MAXT * 256 * D * 2 <= WS_HID && SM_ROWTOK + (size_t)MAXT * 256 * 4 <= WS_RT, "d_ws map");
constexpr int CW_TMO = 0, CW_CODE = 1, CW_BAR = 1024, CW_CUR = 4608;
static_assert((CW_CUR + 64) * 4 <= (int)CTL_ZERO_BYTES && CW_BAR + 3456 <= CW_CUR, "CTL words inside the memset region");

constexpr int RING_OFF = 0, RING_BYTES = 131072;
constexpr int LDS_BYTES = 163840;
constexpr int LDSCTL_OFF = LDS_BYTES - 512, MISC_OFF = LDSCTL_OFF + 320;
constexpr int EXB = 147456;
constexpr int EX_DL = EXB;
constexpr int EX_TE = EXB + 4 * 132 * 4;
constexpr int EX_OFF = EX_TE + 320 * 4;
constexpr int EX_CNT = EX_OFF + 40 * 4;
constexpr int EX_HIST = EX_CNT + 40 * 4;
constexpr int EX_ROW = EX_HIST + 64 * 4;
constexpr int EX_SM = EXB + 5120;
static_assert(EX_SM + 8192 <= LDSCTL_OFF, "LDS map");
static_assert(attn_body::ATTN_LDS_BYTES <= EXB, "attention scratch vs LDS map");
static_assert(EX_ROW + 1024 <= EX_SM, "LDS map");

#define GAS __attribute__((address_space(1)))
#define LAS __attribute__((address_space(3)))
typedef unsigned short bf16;
typedef unsigned v4u __attribute__((ext_vector_type(4)));
typedef unsigned v2u __attribute__((ext_vector_type(2)));
typedef float f32x4 __attribute__((ext_vector_type(4)));
typedef short bf16x8 __attribute__((ext_vector_type(8)));
typedef GAS unsigned gu32;
typedef GAS unsigned long long gu64;
#define RLX_AGENT __ATOMIC_RELAXED, __HIP_MEMORY_SCOPE_AGENT
#define LDS_WAIT() asm volatile("s_waitcnt lgkmcnt(0)" ::: "memory")
#define VM_WAIT() asm volatile("s_waitcnt vmcnt(0)" ::: "memory")
__device__ __forceinline__ unsigned f2bf(float f) { unsigned u = __builtin_bit_cast(unsigned, f); return (u + 0x7fffu + ((u >> 16) & 1u)) >> 16; }
__device__ __forceinline__ unsigned pk2(float lo, float hi) { return f2bf(lo) | (f2bf(hi) << 16); }
__device__ __forceinline__ float bflo(unsigned w) { return __builtin_bit_cast(float, w << 16); }
__device__ __forceinline__ float bfhi(unsigned w) { return __builtin_bit_cast(float, w & 0xffff0000u); }
__device__ __forceinline__ float bf1(unsigned short h) { return __builtin_bit_cast(float, (unsigned)h << 16); }
__device__ __forceinline__ float fast_exp(float x) { return __builtin_amdgcn_exp2f(x * LOG2E); }
__device__ __forceinline__ float sigmoidf_(float x) { return __builtin_amdgcn_rcpf(1.0f + __builtin_amdgcn_exp2f(-LOG2E * x)); }

#define XB_TMO      128
#define XB_XCNT(j)  (256  + 64 * (j))
#define XB_XSUB(j)  (1280 + 64 * (j))
#define XB_XGEN(j)  (2304 + 64 * (j))
#define XB_TOP      3328
#define XB_TOPGEN   3392
#define XCD_BAR_WORDS 3456
#define XB_SPIN_CAP (1u << 18)

__device__ __forceinline__ unsigned xb_ld(unsigned* p)              { return __hip_atomic_load(p, __ATOMIC_RELAXED, __HIP_MEMORY_SCOPE_AGENT); }
__device__ __forceinline__ unsigned xb_add(unsigned* p, unsigned v) { return __hip_atomic_fetch_add(p, v, __ATOMIC_RELAXED, __HIP_MEMORY_SCOPE_AGENT); }
__device__ __forceinline__ unsigned xb_xcc_id() { return (unsigned)__builtin_amdgcn_s_getreg((3 << 11) | 20) & 0xFu; }
#define XB_SPIN(cond, bar) do { unsigned _sp = 0; while (cond) { __builtin_amdgcn_s_sleep(1); \
    if ((++_sp & 255u) == 0u) { if (xb_ld(&(bar)[XB_TMO])) break; if (_sp > XB_SPIN_CAP) { atomicAdd(&(bar)[XB_TMO], 1u); break; } } } } while (0)

struct XcdBarrier {
    unsigned* bar; unsigned x;
    volatile LAS unsigned* st;
};

__device__ __forceinline__ XcdBarrier xcd_barrier_post(unsigned* bar, volatile LAS unsigned* st) {
    XcdBarrier b; b.bar = bar; b.x = xb_xcc_id(); b.st = st;
    if (threadIdx.x == 0) (void)xb_add(&bar[XB_XCNT(b.x)], 1u);
    return b;
}
__device__ __forceinline__ void xcd_barrier_complete(unsigned* bar, unsigned x, unsigned& nloc, unsigned& nx) {
    const unsigned G = gridDim.x * gridDim.y * gridDim.z;
    unsigned sum, cnt, mine, sp = 0u;
    for (;;) {
        sum = 0u; cnt = 0u; mine = 0u;
#pragma unroll
        for (unsigned j = 0; j < 16; ++j) { const unsigned c = xb_ld(&bar[XB_XCNT(j)]); sum += c; cnt += (c > 0u) ? 1u : 0u; mine = (j == x) ? c : mine; }
        if (sum == G) break;
        __builtin_amdgcn_s_sleep(1);
        if ((++sp & 255u) == 0u) { if (xb_ld(&bar[XB_TMO])) break; if (sp > XB_SPIN_CAP) { atomicAdd(&bar[XB_TMO], 1u); break; } }
    }
    nloc = mine > 0u ? mine : 1u; nx = cnt > 0u ? cnt : 1u;
}

__device__ __forceinline__ void xcd_barrier(const XcdBarrier& b) {
    asm volatile("s_waitcnt vmcnt(0)" ::: "memory");
    __syncthreads();
    if (threadIdx.x == 0) {
        unsigned* bar = b.bar;
        __builtin_amdgcn_s_waitcnt(0);
        unsigned nloc = b.st[0], nx = b.st[1];
        if (nloc == 0u) { xcd_barrier_complete(bar, b.x, nloc, nx); b.st[0] = nloc; b.st[1] = nx; }
        const unsigned old = xb_add(&bar[XB_XSUB(b.x)], 1u);
        const unsigned gen = old / nloc;
        if (old + 1u == (gen + 1u) * nloc) {
            __builtin_amdgcn_fence(__ATOMIC_RELEASE, "agent");
            asm volatile("s_waitcnt vmcnt(0)" ::: "memory");
            const unsigned og = xb_add(&bar[XB_TOP], 1u);
            const unsigned tg = og / nx;
            if (og + 1u == (tg + 1u) * nx) xb_add(&bar[XB_TOPGEN], 1u);
            else XB_SPIN(xb_ld(&bar[XB_TOPGEN]) == tg, bar);
            __builtin_amdgcn_fence(__ATOMIC_ACQUIRE, "agent");
            xb_add(&bar[XB_XGEN(b.x)], 1u);
            asm volatile("s_waitcnt vmcnt(0)" ::: "memory");
        } else {
            XB_SPIN(xb_ld(&bar[XB_XGEN(b.x)]) == gen, bar);
            __builtin_amdgcn_fence(__ATOMIC_ACQUIRE, "agent");
            asm volatile("s_waitcnt vmcnt(0)" ::: "memory");
        }
    }
    __syncthreads();
}


struct Frame {
    LAS unsigned char* lds;
    volatile LAS unsigned* MISC;
    gu32* ctl;
    int tid, lane, wave;
    int vcu, G;
    unsigned char* ws;
    const float* in[24]; float* out; int rep9;
};
enum { I_X = 0, I_WIN, I_CONVW, I_CONVB, I_WMQ, I_WMK, I_WMGATE, I_BMGATE, I_MNORMG, I_MSKIP, I_LAMQK, I_DANORMG, I_RELBIAS, I_WOUT, I_NORM1G, I_NORM2G, I_WRG, I_BRG, I_WRE, I_BRE, I_WEG, I_WEU, I_WED, I_NORMFG };

__device__ __forceinline__ float wave_sum(float v) {
#pragma unroll
    for (int o = 1; o < 64; o <<= 1) v += __shfl_xor(v, o);
    return v;
}
__device__ __forceinline__ float wave_max(float v) {
#pragma unroll
    for (int o = 1; o < 64; o <<= 1) v = fmaxf(v, __shfl_xor(v, o));
    return v;
}
__device__ __forceinline__ int t128(int r, int c8) { const int f = ((r & 3) << 1) | ((r >> 2) & 1) | ((((r >> 2) ^ (r >> 3)) & 1) << 3); return r * 256 + ((c8 ^ f) << 4); }
__device__ __forceinline__ int t128e(int r, int c) { return t128(r, c >> 3) + (c & 7) * 2; }

template <bool TRANS> __device__ __forceinline__ void mm128(const LAS unsigned char* A, const LAS unsigned char* B, f32x4 (&acc)[2][4], int wm, int wn, int fr, int fq) {
#pragma unroll
    for (int ks = 0; ks < 4; ++ks) {
        bf16x8 a[2], b[4];
#pragma unroll
        for (int i = 0; i < 2; ++i) a[i] = *(const LAS bf16x8*)(A + t128(wm * 32 + i * 16 + fr, ks * 4 + fq));
#pragma unroll
        for (int j = 0; j < 4; ++j) b[j] = *(const LAS bf16x8*)(B + t128(wn * 64 + j * 16 + fr, ks * 4 + fq));
#pragma unroll
        for (int i = 0; i < 2; ++i)
#pragma unroll
            for (int j = 0; j < 4; ++j) acc[i][j] = TRANS ? __builtin_amdgcn_mfma_f32_16x16x32_bf16(b[j], a[i], acc[i][j], 0, 0, 0) : __builtin_amdgcn_mfma_f32_16x16x32_bf16(a[i], b[j], acc[i][j], 0, 0, 0);
    }
}

typedef short v4i16_t __attribute__((ext_vector_type(4)));
__device__ __forceinline__ bf16x8 frag_tr(const LAS unsigned char* T, int n0, int ks, int lane) {
    const int g = lane >> 4, i = lane & 15, q = i >> 2, p = i & 3, s = 32 * ks + 8 * g + q, ch = (n0 >> 3) + (p >> 1);
    const v4i16_t lo = __builtin_amdgcn_ds_read_tr16_b64_v4i16((LAS v4i16_t*)(T + t128(s, ch) + (p & 1) * 8));
    const v4i16_t hi = __builtin_amdgcn_ds_read_tr16_b64_v4i16((LAS v4i16_t*)(T + t128(s + 4, ch) + (p & 1) * 8));
    return (bf16x8){lo[0], lo[1], lo[2], lo[3], hi[0], hi[1], hi[2], hi[3]};
}
__device__ __forceinline__ int pi64(int c) { return (c & ~63) + 16 * ((c >> 2) & 3) + 4 * ((c >> 4) & 3) + (c & 3); }
__device__ __forceinline__ bf16x8 frag_tr_w(const LAS unsigned char* T, int nb, int j, int ks, int lane) {
    const int g = lane >> 4, i = lane & 15, q = i >> 2, p = i & 3, s = 32 * ks + 8 * g + q, ch = (nb >> 3) + 2 * p + (j >> 1);
    const v4i16_t lo = __builtin_amdgcn_ds_read_tr16_b64_v4i16((LAS v4i16_t*)(T + t128(s, ch) + (j & 1) * 8));
    const v4i16_t hi = __builtin_amdgcn_ds_read_tr16_b64_v4i16((LAS v4i16_t*)(T + t128(s + 4, ch) + (j & 1) * 8));
    return (bf16x8){lo[0], lo[1], lo[2], lo[3], hi[0], hi[1], hi[2], hi[3]};
}
__device__ __forceinline__ void mm128_xb(const LAS unsigned char* A, const LAS unsigned char* X, f32x4 (&acc)[2][4], int wm, int wn, int fr, int fq, int lane) {
#pragma unroll
    for (int ks = 0; ks < 4; ++ks) {
        bf16x8 a[2], b[4];
#pragma unroll
        for (int i = 0; i < 2; ++i) a[i] = *(const LAS bf16x8*)(A + t128(wm * 32 + i * 16 + fr, ks * 4 + fq));
#pragma unroll
        for (int j = 0; j < 4; ++j) b[j] = frag_tr_w(X, wn * 64, j, ks, lane);
#pragma unroll
        for (int i = 0; i < 2; ++i)
#pragma unroll
            for (int j = 0; j < 4; ++j) acc[i][j] = __builtin_amdgcn_mfma_f32_16x16x32_bf16(b[j], a[i], acc[i][j], 0, 0, 0);
    }
}
__device__ __forceinline__ void mm128_xx(const LAS unsigned char* Y, const LAS unsigned char* X, f32x4 (&acc)[2][4], int wm, int wn, int lane) {
#pragma unroll
    for (int ks = 0; ks < 4; ++ks) {
        bf16x8 a[2], b[4];
#pragma unroll
        for (int i = 0; i < 2; ++i) a[i] = frag_tr(Y, wm * 32 + i * 16, ks, lane);
#pragma unroll
        for (int j = 0; j < 4; ++j) b[j] = frag_tr_w(X, wn * 64, j, ks, lane);
#pragma unroll
        for (int i = 0; i < 2; ++i)
#pragma unroll
            for (int j = 0; j < 4; ++j) acc[i][j] = __builtin_amdgcn_mfma_f32_16x16x32_bf16(b[j], a[i], acc[i][j], 0, 0, 0);
    }
}

__device__ __forceinline__ void p0_tr_item(const float* W, int K, int N, bf16* WT, int drow0, LAS float* scr, int kb, int nb, int lane, const float* ksc = nullptr) {
    const int k0 = 64 * kb, n0 = 32 * nb;
    float wv[32];
#pragma unroll
    for (int i = 0; i < 32; ++i) { const int kk = 2 * i + (lane >> 5); wv[i] = W[(size_t)(k0 + kk) * N + n0 + (lane & 31)]; }
#pragma unroll
    for (int i = 0; i < 32; ++i) { const int kk = 2 * i + (lane >> 5); scr[kk * 33 + (lane & 31)] = wv[i]; }
    LDS_WAIT(); asm volatile("" ::: "memory");
    const int c = lane & 7;
    f32x4 k0v = (f32x4){1.f, 1.f, 1.f, 1.f}, k1v = k0v; if (ksc) { k0v = *(const GAS f32x4*)(ksc + k0 + 8 * c); k1v = *(const GAS f32x4*)(ksc + k0 + 8 * c + 4); }
#pragma unroll
    for (int j = 0; j < 4; ++j) { const int n = (lane >> 3) + 8 * j; const LAS float* s = scr + (8 * c) * 33 + n;
        v4u o; o.x = pk2(s[0 * 33] * k0v.x, s[1 * 33] * k0v.y); o.y = pk2(s[2 * 33] * k0v.z, s[3 * 33] * k0v.w); o.z = pk2(s[4 * 33] * k1v.x, s[5 * 33] * k1v.y); o.w = pk2(s[6 * 33] * k1v.z, s[7 * 33] * k1v.w);
        *(GAS v4u*)(WT + (size_t)(drow0 + n) * K + k0 + 8 * c) = o; }
    LDS_WAIT(); asm volatile("" ::: "memory");
}
__device__ __forceinline__ void p0_tr_item8(const float* W, int K, int N, unsigned char* WT8, int drow0, LAS float* scr, int kb, int nb, int lane, const float* ksc, float mult) {
    const int k0 = 64 * kb, n0 = 32 * nb;
    float wv[32];
#pragma unroll
    for (int i = 0; i < 32; ++i) { const int kk = 2 * i + (lane >> 5); wv[i] = W[(size_t)(k0 + kk) * N + n0 + (lane & 31)]; }
#pragma unroll
    for (int i = 0; i < 32; ++i) { const int kk = 2 * i + (lane >> 5); scr[kk * 33 + (lane & 31)] = wv[i]; }
    LDS_WAIT(); asm volatile("" ::: "memory");
    const int c = lane & 7;
    f32x4 k0v = (f32x4){mult, mult, mult, mult}, k1v = k0v; if (ksc) { k0v = *(const GAS f32x4*)(ksc + k0 + 8 * c) * mult; k1v = *(const GAS f32x4*)(ksc + k0 + 8 * c + 4) * mult; }
#pragma unroll
    for (int j = 0; j < 4; ++j) { const int n = (lane >> 3) + 8 * j; const LAS float* s = scr + (8 * c) * 33 + n;
        const float v[8] = {s[0 * 33] * k0v.x, s[1 * 33] * k0v.y, s[2 * 33] * k0v.z, s[3 * 33] * k0v.w, s[4 * 33] * k1v.x, s[5 * 33] * k1v.y, s[6 * 33] * k1v.z, s[7 * 33] * k1v.w};
        unsigned q0, q1; pg8::pack_fp8x8(v, q0, q1); v2u o; o.x = q0; o.y = q1;
        *(GAS v2u*)(WT8 + (size_t)(drow0 + n) * K + k0 + 8 * c) = o; }
    LDS_WAIT(); asm volatile("" ::: "memory");
}
__device__ __forceinline__ void rms_row_to_bf16(int lane, const float* xrow, const float* g, bf16* orow) {
    const GAS f32x4* xr = (const GAS f32x4*)xrow + lane; const GAS f32x4* gr = (const GAS f32x4*)g + lane;
    f32x4 v[4]; float s = 0.f;
#pragma unroll
    for (int j = 0; j < 4; ++j) { v[j] = xr[64 * j]; s += (v[j].x * v[j].x + v[j].y * v[j].y) + (v[j].z * v[j].z + v[j].w * v[j].w); }
    const float rs = 1.0f / sqrtf(wave_sum(s) * (1.f / D) + EPS_RMS);
    GAS v2u* o8 = (GAS v2u*)orow + lane;
#pragma unroll
    for (int j = 0; j < 4; ++j) { const f32x4 gg = gr[64 * j]; v2u o; o.x = pk2(v[j].x * rs * gg.x, v[j].y * rs * gg.y); o.y = pk2(v[j].z * rs * gg.z, v[j].w * rs * gg.w); o8[64 * j] = o; }
}
typedef const float* cfptr_t;
__device__ __forceinline__ void p_expert_weights(Frame& F) {
    const __attribute__((address_space(4))) cfptr_t* inp = (const __attribute__((address_space(4))) cfptr_t*)__builtin_amdgcn_kernarg_segment_ptr();
    asm volatile("" : "+s"(inp));
    LAS float* scr = (LAS float*)(F.lds + RING_OFF + F.wave * 16384);
    const int gw = F.vcu * NWAVES + F.wave, NGW = F.G * NWAVES, lane = F.lane;
    unsigned char* ws = F.ws;
    constexpr int IE = NEXP * 256;
    struct It { const float* W; unsigned char* WT8; const float* ksc; int K, N, drow0, k0, n0; };
    auto decode = [&](int it) { It t; int r = it;
        if (r < 2 * IE) { const int up = r >= IE; if (up) r -= IE; const int e = r >> 8, q = r & 255, kb = q >> 4, nb = q & 15, n0 = 32 * nb;
            t.W = inp[up ? I_WEU : I_WEG] + (size_t)e * D * FFE; t.K = D; t.N = FFE; t.WT8 = (unsigned char*)(ws + WS_WGU) + (size_t)e * D * D; t.drow0 = (n0 >> 7) * 256 + (n0 & 127) + (up ? 128 : 0); t.ksc = inp[I_NORM2G]; t.k0 = 64 * kb; t.n0 = n0; }
        else { r -= 2 * IE; const int e = r >> 8, q = r & 255, kb = q >> 5, nb = q & 31;
            t.W = inp[I_WED] + (size_t)e * FFE * D; t.K = FFE; t.N = D; t.WT8 = (unsigned char*)(ws + WS_WD) + (size_t)e * D * FFE; t.drow0 = 32 * nb; t.ksc = nullptr; t.k0 = 64 * kb; t.n0 = 32 * nb; }
        return t; };
#define PEW_LOAD(wv, t) do { _Pragma("unroll") for (int i = 0; i < 32; ++i) { const int kk = 2 * i + (lane >> 5); wv[i] = (t).W[(size_t)((t).k0 + kk) * (t).N + (t).n0 + (lane & 31)]; } } while (0)
#define PEW_FINISH(wv, t) do { \
        _Pragma("unroll") for (int i = 0; i < 32; ++i) { const int kk = 2 * i + (lane >> 5); scr[kk * 33 + (lane & 31)] = wv[i]; } \
        LDS_WAIT(); asm volatile("" ::: "memory"); \
        const int c = lane & 7; f32x4 k0v = (f32x4){16.f, 16.f, 16.f, 16.f}, k1v = k0v; \
        if ((t).ksc) { k0v = *(const GAS f32x4*)((t).ksc + (t).k0 + 8 * c) * 16.0f; k1v = *(const GAS f32x4*)((t).ksc + (t).k0 + 8 * c + 4) * 16.0f; } \
        _Pragma("unroll") for (int j = 0; j < 4; ++j) { const int n = (lane >> 3) + 8 * j; const LAS float* sp = scr + (8 * c) * 33 + n; \
            const float v[8] = {sp[0 * 33] * k0v.x, sp[1 * 33] * k0v.y, sp[2 * 33] * k0v.z, sp[3 * 33] * k0v.w, sp[4 * 33] * k1v.x, sp[5 * 33] * k1v.y, sp[6 * 33] * k1v.z, sp[7 * 33] * k1v.w}; \
            unsigned q0, q1; pg8::pack_fp8x8(v, q0, q1); v2u o; o.x = q0; o.y = q1; \
            *(GAS v2u*)((t).WT8 + (size_t)((t).drow0 + n) * (t).K + (t).k0 + 8 * c) = o; } \
        LDS_WAIT(); asm volatile("" ::: "memory"); } while (0)
    float wa[32], wb[32];
    int it = gw; if (it >= 3 * IE) return;
    { const It t = decode(it); PEW_LOAD(wa, t); }
    for (;;) {
        const bool hb = it + NGW < 3 * IE; if (hb) { const It t = decode(it + NGW); PEW_LOAD(wb, t); }
        { const It t = decode(it); PEW_FINISH(wa, t); } if (!hb) break; it += NGW;
        const bool ha = it + NGW < 3 * IE; if (ha) { const It t = decode(it + NGW); PEW_LOAD(wa, t); }
        { const It t = decode(it); PEW_FINISH(wb, t); } if (!ha) break; it += NGW;
    }
#undef PEW_LOAD
#undef PEW_FINISH
}
__device__ __forceinline__ void p0_prologue(Frame& F) {
    LAS float* scr = (LAS float*)(F.lds + RING_OFF + F.wave * 16384);
    const int gw = F.vcu * NWAVES + F.wave, NGW = F.G * NWAVES;
    unsigned char* ws = F.ws;
    constexpr int I0 = 16 * 96, I1 = 16 * 32, IH = NH * 8;
    constexpr int NITEMS = I0 + I1 + 2 * IH;
    for (int it = gw; it < NITEMS; it += NGW) {
        int r = it;
        if (r < I0) { p0_tr_item(F.in[I_WIN], D, NPROJ, (bf16*)(ws + WS_WIN), 32 * (r % 96), scr, r / 96, r % 96, F.lane, F.in[I_NORM1G]); continue; } r -= I0;
        if (r < I1) { p0_tr_item(F.in[I_WOUT], D, D, (bf16*)(ws + WS_WOUT), 32 * (r % 32), scr, r / 32, r % 32, F.lane); continue; } r -= I1;
        { const int k = r >= IH; if (k) r -= IH; const int h = r >> 3, q = r & 7, kb = q >> 2, nb = q & 3;
            p0_tr_item(F.in[k ? I_WMK : I_WMQ] + (size_t)h * HD * HD, HD, HD, (bf16*)(ws + (k ? WS_WK : WS_WQ)) + (size_t)h * HD * HD, 32 * nb, scr, kb, nb, F.lane); }
    }
    { bf16* wrt = (bf16*)(ws + WS_WR); const float* wrg = F.in[I_WRG]; const float* wre = F.in[I_WRE]; const float* g2 = F.in[I_NORM2G];
      for (int idx = (F.vcu * NWAVES + F.wave) * 64 + F.lane; idx < 48 * D; idx += F.G * NWAVES * 64) { const int p = idx >> 10, k = idx & 1023, j = p >> 4, g = (p >> 2) & 3, r = p & 3;
          float v = 0.f; if (j < 2) v = wre[(size_t)k * 32 + g * 8 + j * 4 + r]; else if (r == 0) v = wrg[(size_t)k * 4 + g];
          wrt[idx] = (bf16)f2bf(v * g2[k]); } }
    { bf16* wct = (bf16*)(ws + WS_WC); const float* wg = F.in[I_WMGATE]; const float* wq = F.in[I_WMQ]; const float* wk = F.in[I_WMK];
      for (int o = gw; o < 8 * DH; o += NGW) { const int g = o >> 9, ch = o & 511, h = ch >> 7, d = ch & 127; float a = 0.f;
#pragma unroll
          for (int eh = 0; eh < 2; ++eh) { const int e = F.lane + 64 * eh; a += wq[(size_t)(h * HD + d) * HD + e] * wg[(size_t)(h * HD + e) * 8 + g] + wk[(size_t)(h * HD + d) * HD + e] * wg[(size_t)(DH + h * HD + e) * 8 + g]; }
          a = wave_sum(a); if (F.lane == 0) wct[g * D + ch] = (bf16)f2bf(a); }
      for (int idx = (F.vcu * NWAVES + F.wave) * 64 + F.lane; idx < 8 * DH; idx += F.G * NWAVES * 64) { const int g = idx >> 9, ch = idx & 511; wct[g * D + DH + ch] = (bf16)f2bf(wg[(size_t)(2 * DH + ch) * 8 + g]); } }
    { bf16* wgt = (bf16*)(ws + WS_WG); const float* wg = F.in[I_WMGATE];
      for (int idx = (F.vcu * NWAVES + F.wave) * 64 + F.lane; idx < 8 * 1536; idx += F.G * NWAVES * 64) { const int g = idx / 1536, j = idx % 1536; wgt[idx] = (bf16)f2bf(wg[j * 8 + g]); } }
    {
        const float* x = F.in[I_X]; bf16* H = (bf16*)(ws + WS_HB); float* RMS1 = (float*)(ws + SM_RMS1); const int lane = F.lane;
        for (int m0 = gw; m0 < M; m0 += 4 * NGW) {
            f32x4 v[4][4];
#pragma unroll
            for (int q = 0; q < 4; ++q) { const int m = m0 + q * NGW; const GAS f32x4* xr = (const GAS f32x4*)(x + (size_t)(m < M ? m : 0) * D) + lane;
#pragma unroll
                for (int j = 0; j < 4; ++j) v[q][j] = xr[64 * j]; }
#pragma unroll
            for (int q = 0; q < 4; ++q) { const int m = m0 + q * NGW; if (m >= M) break;
                float s = 0.f;
#pragma unroll
                for (int j = 0; j < 4; ++j) s += (v[q][j].x * v[q][j].x + v[q][j].y * v[q][j].y) + (v[q][j].z * v[q][j].z + v[q][j].w * v[q][j].w);
                const float rms = sqrtf(wave_sum(s) * (1.f / D) + EPS_RMS), rs = 1.0f / rms; if (lane == 0) RMS1[m] = rms;
                GAS v2u* o8 = (GAS v2u*)(H + (size_t)m * D) + lane;
#pragma unroll
                for (int j = 0; j < 4; ++j) { v2u o; o.x = pk2(v[q][j].x * rs, v[q][j].y * rs); o.y = pk2(v[q][j].z * rs, v[q][j].w * rs); o8[64 * j] = o; } }
        }
    }
}

__device__ __forceinline__ void p2_mfront(Frame& F) {
    unsigned char* ws = F.ws;
    const bf16* PC = (const bf16*)(ws + WS_PC); const bf16* PV = (const bf16*)(ws + WS_PV);
    bf16* CA = (bf16*)(ws + WS_CA); bf16* MQ = (bf16*)(ws + WS_MQ); bf16* MK = (bf16*)(ws + WS_MK);
    const bf16* WQT = (const bf16*)(ws + WS_WQ); const bf16* WKT = (const bf16*)(ws + WS_WK); const bf16* WCT = (const bf16*)(ws + WS_WC);
    float* GI = (float*)(ws + SM_GI); float* GF = (float*)(ws + SM_GF);
    const float* convw = F.in[I_CONVW]; const float* convb = F.in[I_CONVB]; const float* bg = F.in[I_BMGATE];
    LAS unsigned char* T_CA = F.lds; LAS unsigned char* T_V = F.lds + 32768; LAS unsigned char* T_Q = F.lds + 65536; LAS unsigned char* T_K = F.lds + 98304;
    LAS float* sCW = (LAS float*)(F.lds + RING_BYTES);
    const int tid0 = F.tid, lane0 = F.lane, wid = F.wave, wm = wid >> 1, wn = wid & 1;
    int tid = tid0, lane = lane0, fr = lane & 15, fq = lane >> 4, c8 = tid & 15, tg = tid >> 4;
    for (int i = tid0; i < 5 * DH / 4; i += NWAVES * 64) *(LAS f32x4*)(sCW + 4 * i) = (i < DH) ? *(const GAS f32x4*)(convw + 4 * i) : *(const GAS f32x4*)(convb + 4 * (i - DH));
    v4u xr[7], vr[4], wqv[4], wkv[4];
#define P2_U(jj) (F.vcu + ((jj) >> 2) * F.G)
#define P2_LOAD(jj) do { const int u_ = P2_U(jj), h_ = (jj) & 3, tok0_ = u_ * CHUNK, s0_ = (u_ % NCH) * CHUNK, col_ = h_ * HD + c8 * 8, t0_ = 4 * tg; \
        _Pragma("unroll") for (int j = 0; j < 7; ++j) { const int tt = t0_ - 3 + j, tc = (s0_ + tt >= 0) ? tt : 0; xr[j] = *(const GAS v4u*)(PC + (size_t)(tok0_ + tc) * DH + col_); }     \
        _Pragma("unroll") for (int j = 0; j < 4; ++j) { vr[j] = *(const GAS v4u*)(PV + (size_t)(tok0_ + t0_ + j) * DH + col_); \
            wqv[j] = *(const GAS v4u*)(WQT + (size_t)h_ * HD * HD + (size_t)(tg + 32 * j) * HD + c8 * 8); wkv[j] = *(const GAS v4u*)(WKT + (size_t)h_ * HD * HD + (size_t)(tg + 32 * j) * HD + c8 * 8); } } while (0)
    __syncthreads();
    if (P2_U(0) < BATCH * NCH) P2_LOAD(0);
    f32x4 gacc = (f32x4){0.f, 0.f, 0.f, 0.f};
    for (int jj = 0; P2_U(jj) < BATCH * NCH; ++jj) {
        const int u = P2_U(jj), h = jj & 3, tok0 = u * CHUNK, s0 = (u % NCH) * CHUNK;
        { int zl = 0; asm volatile("" : "+v"(zl)); tid = tid0 + zl; lane = lane0 + zl; fr = lane & 15; fq = lane >> 4; c8 = tid & 15; tg = tid >> 4; }
        if (h == 0) gacc = (f32x4){0.f, 0.f, 0.f, 0.f};
        {
            const int col = h * HD + c8 * 8, t0 = 4 * tg;
#pragma unroll
            for (int j = 0; j < 4; ++j) { *(LAS v4u*)(T_Q + t128(pi64(tg + 32 * j), c8)) = wqv[j]; *(LAS v4u*)(T_K + t128(pi64(tg + 32 * j), c8)) = wkv[j]; *(LAS v4u*)(T_V + t128(t0 + j, c8)) = vr[j]; }
            f32x4 cw[4][2], cb[2];
#pragma unroll
            for (int j = 0; j < 4; ++j) { cw[j][0] = *(const LAS f32x4*)(sCW + j * DH + col); cw[j][1] = *(const LAS f32x4*)(sCW + j * DH + col + 4); }
            cb[0] = *(const LAS f32x4*)(sCW + 4 * DH + col); cb[1] = *(const LAS f32x4*)(sCW + 4 * DH + col + 4);
#pragma unroll
            for (int q = 0; q < 4; ++q) {
                float a[8] = {cb[0].x, cb[0].y, cb[0].z, cb[0].w, cb[1].x, cb[1].y, cb[1].z, cb[1].w};
#pragma unroll
                for (int j = 0; j < 4; ++j) { v4u xv = xr[q + j]; if (s0 + t0 - 3 + q + j < 0) xv = (v4u){0u, 0u, 0u, 0u}; const f32x4 w0 = cw[j][0], w1 = cw[j][1];
                    a[0] += w0.x * bflo(xv.x); a[1] += w0.y * bfhi(xv.x); a[2] += w0.z * bflo(xv.y); a[3] += w0.w * bfhi(xv.y);
                    a[4] += w1.x * bflo(xv.z); a[5] += w1.y * bfhi(xv.z); a[6] += w1.z * bflo(xv.w); a[7] += w1.w * bfhi(xv.w); }
#pragma unroll
                for (int i = 0; i < 8; ++i) a[i] = a[i] * sigmoidf_(a[i]);
                v4u o; o.x = pk2(a[0], a[1]); o.y = pk2(a[2], a[3]); o.z = pk2(a[4], a[5]); o.w = pk2(a[6], a[7]);
                *(LAS v4u*)(T_CA + t128(t0 + q, c8)) = o;
                *(GAS v4u*)(CA + (size_t)(tok0 + t0 + q) * DH + col) = o;
            }
        }
        if (P2_U(jj + 1) < BATCH * NCH) P2_LOAD(jj + 1);
        bf16x8 wgf[8];
#pragma unroll
        for (int q = 0; q < 8; ++q) wgf[q] = *(const GAS bf16x8*)(WCT + (size_t)(fr & 7) * D + (q >> 2) * DH + h * HD + (q & 3) * 32 + fq * 8);
        __syncthreads();
        {
            f32x4 aq[2][4], ak[2][4];
#pragma unroll
            for (int i = 0; i < 2; ++i)
#pragma unroll
                for (int j = 0; j < 4; ++j) { aq[i][j] = (f32x4){0.f, 0.f, 0.f, 0.f}; ak[i][j] = (f32x4){0.f, 0.f, 0.f, 0.f}; }
            mm128<true>(T_CA, T_Q, aq, wm, wn, fr, fq);
            mm128<true>(T_CA, T_K, ak, wm, wn, fr, fq);
#pragma unroll
            for (int src = 0; src < 2; ++src) {
                const LAS unsigned char* T = src == 0 ? T_CA : T_V;
#pragma unroll
                for (int ks = 0; ks < 4; ++ks) { const bf16x8 a = *(const LAS bf16x8*)(T + t128(wid * 16 + fr, ks * 4 + fq)); gacc = __builtin_amdgcn_mfma_f32_16x16x32_bf16(a, wgf[src * 4 + ks], gacc, 0, 0, 0); }
            }
#pragma unroll
            for (int i = 0; i < 2; ++i)
#pragma unroll
                for (int jp = 0; jp < 2; ++jp) { const int t = wm * 32 + i * 16 + fr, e = wn * 64 + 16 * fq + 8 * jp;
                    v4u q4v, k4v; q4v.x = pk2(aq[i][2 * jp][0], aq[i][2 * jp][1]); q4v.y = pk2(aq[i][2 * jp][2], aq[i][2 * jp][3]); q4v.z = pk2(aq[i][2 * jp + 1][0], aq[i][2 * jp + 1][1]); q4v.w = pk2(aq[i][2 * jp + 1][2], aq[i][2 * jp + 1][3]);
                    k4v.x = pk2(ak[i][2 * jp][0], ak[i][2 * jp][1]); k4v.y = pk2(ak[i][2 * jp][2], ak[i][2 * jp][3]); k4v.z = pk2(ak[i][2 * jp + 1][0], ak[i][2 * jp + 1][1]); k4v.w = pk2(ak[i][2 * jp + 1][2], ak[i][2 * jp + 1][3]);
                    *(GAS v4u*)(MQ + (size_t)(tok0 + t) * DH + h * HD + e) = q4v; *(GAS v4u*)(MK + (size_t)(tok0 + t) * DH + h * HD + e) = k4v; }
        }
        if (h == NH - 1 && fr < 8) {
            const float bias = bg[fr];
#pragma unroll
            for (int r = 0; r < 4; ++r) { const int tok = tok0 + wid * 16 + fq * 4 + r; const float v = gacc[r] + bias;
                if (fr < 4) GI[(size_t)tok * 4 + fr] = v; else GF[(size_t)tok * 4 + (fr - 4)] = fminf(v, 0.f) - log1pf(__expf(-fabsf(v))); }
        }
        __syncthreads();
    }
#undef P2_LOAD
#undef P2_U
}

__device__ __forceinline__ void p3_mlocal(Frame& F) {
    unsigned char* ws = F.ws;
    const bf16* PV = (const bf16*)(ws + WS_PV); const bf16* MK = (const bf16*)(ws + WS_MK);
    const float* GI = (const float*)(ws + SM_GI); const float* GF = (const float*)(ws + SM_GF); float* GB = (float*)(ws + SM_GB);
    float* GMAX = (float*)(ws + SM_GMAX); float* BEND = (float*)(ws + SM_BEND); bf16* DC = (bf16*)F.out; float* DN = (float*)(ws + SM_DN);
    LAS unsigned char* T_V = F.lds; LAS unsigned char* T_K = F.lds + 32768; LAS float* sWK = (LAS float*)(F.lds + EX_SM); LAS float* sDN = sWK + 128;
    const int tid0 = F.tid, lane0 = F.lane, wid = F.wave, wm = wid >> 1, wn = wid & 1;
    int tid = tid0, lane = lane0, fr = lane & 15, fq = lane >> 4, c8 = tid & 15, sg = tid >> 4;
    v4u vv4[4], kv4[4]; float f0 = 0.f, f1 = 0.f, i0 = 0.f, i1 = 0.f;
#define P3_LOAD(uu) do { const int c_ = (uu) % NCH, bh_ = (uu) / NCH, h_ = bh_ % NH, b_ = bh_ / NH, tok0_ = b_ * SEQ + c_ * CHUNK; \
        _Pragma("unroll") for (int q = 0; q < 4; ++q) { const size_t go = (size_t)(tok0_ + sg + 32 * q) * DH + h_ * HD + c8 * 8; vv4[q] = *(const GAS v4u*)(PV + go); kv4[q] = *(const GAS v4u*)(MK + go); } \
        if (wid == 0) { f0 = GF[(size_t)(tok0_ + 2 * lane) * 4 + h_]; f1 = GF[(size_t)(tok0_ + 2 * lane + 1) * 4 + h_]; i0 = GI[(size_t)(tok0_ + 2 * lane) * 4 + h_]; i1 = GI[(size_t)(tok0_ + 2 * lane + 1) * 4 + h_]; } } while (0)
#define P3_U(jj) (F.vcu + ((jj) >> 2) * F.G)
#define P3_U3(jj) ((((P3_U(jj) >> 5) * NH + ((jj) & 3)) * NCH) + (P3_U(jj) & 31))
    asm volatile("s_waitcnt vmcnt(0)" ::: "memory"); __syncthreads();
    if (tid0 == 0) { __builtin_amdgcn_fence(__ATOMIC_ACQUIRE, "agent"); asm volatile("s_waitcnt vmcnt(0)" ::: "memory"); }
    __syncthreads();
    int jj = 0;
    if (P3_U(0) < BATCH * NCH) P3_LOAD(P3_U3(0));
    for (; P3_U(jj) < BATCH * NCH; ++jj) {
        const int u3 = P3_U3(jj);
        const int c = u3 % NCH, bh = u3 / NCH, h = bh % NH, b = bh / NH, tok0 = b * SEQ + c * CHUNK;
        { int zl = 0; asm volatile("" : "+v"(zl)); tid = tid0 + zl; lane = lane0 + zl; fr = lane & 15; fq = lane >> 4; c8 = tid & 15; sg = tid >> 4; }
        if (wid == 0) {
            float incl = f0 + f1;
#pragma unroll
            for (int o = 1; o < 64; o <<= 1) { const float y = __shfl_up(incl, o); if (lane >= o) incl += y; }
            const float b1 = incl, b0 = incl - f1, bend = __shfl(incl, 63);
            GB[(size_t)(tok0 + 2 * lane) * 4 + h] = b0; GB[(size_t)(tok0 + 2 * lane + 1) * 4 + h] = b1;
            const float g0 = bend - b0 + i0, g1 = bend - b1 + i1, gm = wave_max(fmaxf(g0, g1));
            sWK[2 * lane] = __expf(g0 - gm) * KSCALE; sWK[2 * lane + 1] = __expf(g1 - gm) * KSCALE;
            if (lane == 0) { GMAX[u3] = gm; BEND[u3] = bend; }
        }
#pragma unroll
        for (int q = 0; q < 4; ++q) *(LAS v4u*)(T_V + t128(sg + 32 * q, c8)) = vv4[q];
        __syncthreads();
#pragma unroll
        for (int q = 0; q < 4; ++q) { const int s = sg + 32 * q; const float wk = sWK[s]; const v4u kv = kv4[q];
            v4u o; o.x = pk2(bflo(kv.x) * wk, bfhi(kv.x) * wk); o.y = pk2(bflo(kv.y) * wk, bfhi(kv.y) * wk); o.z = pk2(bflo(kv.z) * wk, bfhi(kv.z) * wk); o.w = pk2(bflo(kv.w) * wk, bfhi(kv.w) * wk);
            *(LAS v4u*)(T_K + t128(s, c8)) = o; }
        if (P3_U(jj + 1) < BATCH * NCH) P3_LOAD(P3_U3(jj + 1));
        __syncthreads();
        {
            f32x4 acc[2][4];
#pragma unroll
            for (int i = 0; i < 2; ++i)
#pragma unroll
                for (int j = 0; j < 4; ++j) acc[i][j] = (f32x4){0.f, 0.f, 0.f, 0.f};
            mm128_xx(T_V, T_K, acc, wm, wn, lane);
            bf16* dc = DC + (size_t)u3 * HD * HD;
#pragma unroll
            for (int i = 0; i < 2; ++i)
#pragma unroll
                for (int jp = 0; jp < 2; ++jp) { v4u o; o.x = pk2(acc[i][2 * jp][0], acc[i][2 * jp][1]); o.y = pk2(acc[i][2 * jp][2], acc[i][2 * jp][3]); o.z = pk2(acc[i][2 * jp + 1][0], acc[i][2 * jp + 1][1]); o.w = pk2(acc[i][2 * jp + 1][2], acc[i][2 * jp + 1][3]);
                    *(GAS v4u*)(dc + (size_t)(wm * 32 + i * 16 + fr) * HD + wn * 64 + 16 * fq + 8 * jp) = o; }
        }
        { const int kk = tid & 127, sq = tid >> 7; float sm = 0.f;
#pragma unroll 8
            for (int r = 0; r < 32; ++r) sm += bf1(*(const LAS unsigned short*)(T_K + t128e(sq * 32 + r, kk)));
            sDN[sq * 128 + kk] = sm; }
        __syncthreads();
        if (tid < HD) DN[(size_t)u3 * HD + tid] = (sDN[tid] + sDN[128 + tid]) + (sDN[256 + tid] + sDN[384 + tid]);
    }
#undef P3_LOAD
#undef P3_U
#undef P3_U3
}

__device__ __forceinline__ void p4_mscan(Frame& F) {
    unsigned char* ws = F.ws;
    const float* GMAX = (const float*)(ws + SM_GMAX); const float* BEND = (const float*)(ws + SM_BEND); const bf16* DC = (const bf16*)F.out; const float* DN = (const float*)(ws + SM_DN);
    float* MPREV = (float*)(ws + SM_MPREV); float* NP = (float*)(ws + SM_NP); bf16* CP = (bf16*)(ws + WS_CP);
    const int gt = (F.vcu * NWAVES + F.wave) * 64 + F.lane, NT = F.G * NWAVES * 64;
    for (int gid = gt; gid < BATCH * NH * 4096; gid += NT) {
        const int bh = gid >> 12, e4 = gid & 4095;
        float m = 0.f; f32x4 C = (f32x4){0.f, 0.f, 0.f, 0.f};
        for (int c0 = 0; c0 < NCH; c0 += 8) {
            f32x4 d[8]; float be[8], gm[8];
#pragma unroll
            for (int q = 0; q < 8; ++q) { const int u3 = bh * NCH + c0 + q; { const v2u w = *(const GAS v2u*)(DC + (size_t)u3 * HD * HD + e4 * 4); d[q] = (f32x4){bflo(w.x), bfhi(w.x), bflo(w.y), bfhi(w.y)}; } be[q] = BEND[u3]; gm[q] = GMAX[u3]; }
#pragma unroll
            for (int q = 0; q < 8; ++q) { const int u3 = bh * NCH + c0 + q;
                v2u o; o.x = pk2(C.x, C.y); o.y = pk2(C.z, C.w);
                *(GAS v2u*)(CP + (size_t)u3 * HD * HD + e4 * 4) = o;
                if (e4 == 0) MPREV[u3] = m;
                const float mn = fmaxf(be[q] + m, gm[q]), dec = __expf(be[q] + m - mn), sl = __expf(gm[q] - mn);
                C = C * dec + d[q] * sl; m = mn; }
        }
    }
    for (int gid = gt; gid < BATCH * NH * HD; gid += NT) {
        const int bh = gid >> 7, k = gid & 127;
        float m = 0.f, n = 0.f;
        for (int c = 0; c < NCH; ++c) {
            const int u3 = bh * NCH + c;
            NP[(size_t)u3 * HD + k] = n;
            const float be = BEND[u3], gm = GMAX[u3], mn = fmaxf(be + m, gm), dec = __expf(be + m - mn), sl = __expf(gm - mn);
            n = n * dec + DN[(size_t)u3 * HD + k] * sl; m = mn;
        }
    }
}

__device__ __forceinline__ void p5_mout(Frame& F) {
    unsigned char* ws = F.ws;
    const bf16* PV = (const bf16*)(ws + WS_PV); const bf16* PZ = (const bf16*)(ws + WS_PZ); const bf16* MQ = (const bf16*)(ws + WS_MQ); const bf16* MK = (const bf16*)(ws + WS_MK);
    const bf16* CA = (const bf16*)(ws + WS_CA); const bf16* CP = (const bf16*)(ws + WS_CP); bf16* A2 = (bf16*)((unsigned char*)F.out + OUT_A2);
    const float* GI = (const float*)(ws + SM_GI); const float* GB = (const float*)(ws + SM_GB); const float* MPREV = (const float*)(ws + SM_MPREV); const float* NP = (const float*)(ws + SM_NP);
    const float* ng = F.in[I_MNORMG]; const float* skip = F.in[I_MSKIP];
    LAS unsigned char* T_Q = F.lds; LAS unsigned char* T_K = F.lds + 32768; LAS unsigned char* T_VT = F.lds + 65536; LAS unsigned char* T_CP = F.lds + 98304;
    LAS float* sA = (LAS float*)(F.lds + EX_SM); LAS float* sB = sA + 128; LAS float* sM = sA + 256; LAS float* sSP = sA + 384; LAS float* sINV = sA + 512; LAS float* sNP = sA + 640; LAS float* sPart = sA + 768;
    const int tid0 = F.tid, lane0 = F.lane, wid = F.wave, wm = wid >> 1, wn = wid & 1;
    int tid = tid0, lane = lane0, fr = lane & 15, fq = lane >> 4, c8 = tid & 15, rg = tid >> 4;
    v4u q4[4], k4[4], c4[4], v4[4]; float gb0 = 0.f, gb1 = 0.f, gi0 = 0.f, gi1 = 0.f, np0 = 0.f, np1 = 0.f, mprev_n = 0.f;
#define P5_LOAD(uu) do { const int c_ = (uu) % NCH, bh_ = (uu) / NCH, h_ = bh_ % NH, b_ = bh_ / NH, tok0_ = b_ * SEQ + c_ * CHUNK; \
        _Pragma("unroll") for (int q = 0; q < 4; ++q) { const int r = rg + 32 * q; const size_t go = (size_t)(tok0_ + r) * DH + h_ * HD + c8 * 8; \
            q4[q] = *(const GAS v4u*)(MQ + go); k4[q] = *(const GAS v4u*)(MK + go); c4[q] = *(const GAS v4u*)(CP + (size_t)(uu) * HD * HD + r * HD + c8 * 8); v4[q] = *(const GAS v4u*)(PV + go); } \
        mprev_n = MPREV[(uu)]; \
        if (wid == 0) { gb0 = GB[(size_t)(tok0_ + 2 * lane) * 4 + h_]; gb1 = GB[(size_t)(tok0_ + 2 * lane + 1) * 4 + h_]; gi0 = GI[(size_t)(tok0_ + 2 * lane) * 4 + h_]; gi1 = GI[(size_t)(tok0_ + 2 * lane + 1) * 4 + h_]; } \
        else if (wid == 1) { np0 = NP[(size_t)(uu) * HD + lane]; np1 = NP[(size_t)(uu) * HD + lane + 64]; } } while (0)
    int u3 = F.vcu;
    if (u3 < NU3) P5_LOAD(u3);
    for (; u3 < NU3; u3 += F.G) {
        const int c = u3 % NCH, bh = u3 / NCH, h = bh % NH, b = bh / NH, tok0 = b * SEQ + c * CHUNK;
        { int zl = 0; asm volatile("" : "+v"(zl)); tid = tid0 + zl; lane = lane0 + zl; fr = lane & 15; fq = lane >> 4; c8 = tid & 15; rg = tid >> 4; }
#pragma unroll
        for (int q = 0; q < 4; ++q) { const int r = rg + 32 * q;
            *(LAS v4u*)(T_Q + t128(r, c8)) = q4[q]; *(LAS v4u*)(T_K + t128(r, c8)) = k4[q]; *(LAS v4u*)(T_CP + t128(pi64(r), c8)) = c4[q]; *(LAS v4u*)(T_VT + t128(r, c8)) = v4[q]; }
        const float mprev = mprev_n;
        if (wid == 0) {
            const float b0 = gb0, b1 = gb1, a0 = gi0 - b0, a1 = gi1 - b1;
            float incl = fmaxf(a0, a1);
#pragma unroll
            for (int o = 1; o < 64; o <<= 1) { const float y = __shfl_up(incl, o); if (lane >= o) incl = fmaxf(incl, y); }
            float excl = __shfl_up(incl, 1); if (lane == 0) excl = -INFINITY;
            const float M0 = fmaxf(fmaxf(mprev, excl), a0), M1 = fmaxf(M0, a1);
            sA[2 * lane] = a0; sA[2 * lane + 1] = a1; sB[2 * lane] = b0; sB[2 * lane + 1] = b1; sM[2 * lane] = M0; sM[2 * lane + 1] = M1;
            sSP[2 * lane] = __expf(mprev - M0); sSP[2 * lane + 1] = __expf(mprev - M1);
        } else if (wid == 1) { sNP[lane] = np0; sNP[lane + 64] = np1; }
        v4u cw[2][2], zw[2][2];
#pragma unroll
        for (int i = 0; i < 2; ++i)
#pragma unroll
            for (int jp = 0; jp < 2; ++jp) { const size_t go = (size_t)(tok0 + wm * 32 + i * 16 + fr) * DH + h * HD + wn * 64 + 16 * fq + 8 * jp; cw[i][jp] = *(const GAS v4u*)(CA + go); zw[i][jp] = *(const GAS v4u*)(PZ + go); }
        if (u3 + F.G < NU3) P5_LOAD(u3 + F.G);
        __syncthreads();
        f32x4 acc[2][4];
        {
            f32x4 accS[2][4];
#pragma unroll
            for (int i = 0; i < 2; ++i)
#pragma unroll
                for (int j = 0; j < 4; ++j) { accS[i][j] = (f32x4){0.f, 0.f, 0.f, 0.f}; acc[i][j] = (f32x4){0.f, 0.f, 0.f, 0.f}; }
            mm128<true>(T_Q, T_K, accS, wm, wn, fr, fq);
            mm128<true>(T_Q, T_CP, acc, wm, wn, fr, fq);
            __syncthreads();
#pragma unroll
            for (int i = 0; i < 2; ++i) { const int t = wm * 32 + i * 16 + fr; const float Mt = sM[t];
#pragma unroll
                for (int j = 0; j < 4; ++j) { const int s = wn * 64 + j * 16 + fq * 4; float w[4];
#pragma unroll
                    for (int r = 0; r < 4; ++r) w[r] = (s + r <= t) ? accS[i][j][r] * KSCALE * __expf(sA[s + r] - Mt) : 0.f;
                    v2u o; o.x = pk2(w[0], w[1]); o.y = pk2(w[2], w[3]); *(LAS v2u*)(T_K + t128e(t, s)) = o; } }
        }
        __syncthreads();
        {
            const int t = tid >> 2, qd = tid & 3; float rs = 0.f, qn = 0.f;
#pragma unroll
            for (int cc = 0; cc < 4; ++cc) { const int ch = qd * 4 + cc; const v4u w = *(const LAS v4u*)(T_K + t128(t, ch)); const v4u q = *(const LAS v4u*)(T_Q + t128(t, ch));
                rs += (bflo(w.x) + bfhi(w.x)) + (bflo(w.y) + bfhi(w.y)) + (bflo(w.z) + bfhi(w.z)) + (bflo(w.w) + bfhi(w.w));
                const LAS float* np = sNP + ch * 8;
                qn += bflo(q.x) * np[0] + bfhi(q.x) * np[1] + bflo(q.y) * np[2] + bfhi(q.y) * np[3] + bflo(q.z) * np[4] + bfhi(q.z) * np[5] + bflo(q.w) * np[6] + bfhi(q.w) * np[7]; }
            rs += __shfl_xor(rs, 1); rs += __shfl_xor(rs, 2); qn += __shfl_xor(qn, 1); qn += __shfl_xor(qn, 2);
            if (qd == 0) { const float den = sSP[t] * qn + rs, mt = sB[t] + sM[t]; sINV[t] = 1.0f / fmaxf(fabsf(den), __expf(-mt)); }
        }
#pragma unroll
        for (int i = 0; i < 2; ++i) { const float sp = sSP[wm * 32 + i * 16 + fr];
#pragma unroll
            for (int j = 0; j < 4; ++j) acc[i][j] = acc[i][j] * sp; }
        mm128_xb(T_K, T_VT, acc, wm, wn, fr, fq, lane);
        __syncthreads();
#pragma unroll
        for (int i = 0; i < 2; ++i) { const int t = wm * 32 + i * 16 + fr; const float inv = sINV[t]; float s1 = 0.f, s2 = 0.f;
#pragma unroll
            for (int j = 0; j < 4; ++j) { acc[i][j] = acc[i][j] * inv;
#pragma unroll
                for (int r = 0; r < 4; ++r) { s1 += acc[i][j][r]; s2 += acc[i][j][r] * acc[i][j][r]; } }
            s1 += __shfl_xor(s1, 16); s1 += __shfl_xor(s1, 32); s2 += __shfl_xor(s2, 16); s2 += __shfl_xor(s2, 32);
            if (fq == 0) { sPart[(t * 2 + wn) * 2] = s1; sPart[(t * 2 + wn) * 2 + 1] = s2; } }
        __syncthreads();
#pragma unroll
        for (int i = 0; i < 2; ++i) { const int t = wm * 32 + i * 16 + fr;
            const float s1 = sPart[t * 4] + sPart[t * 4 + 2], s2 = sPart[t * 4 + 1] + sPart[t * 4 + 3];
            const float mu = s1 * (1.f / HD), var = fmaxf(s2 * (1.f / HD) - mu * mu, 0.f), rstd = 1.0f / sqrtf(var + EPS_RMS);
#pragma unroll
            for (int jp = 0; jp < 2; ++jp) { const int col = h * HD + wn * 64 + 16 * fq + 8 * jp; v4u o;
#pragma unroll
                for (int jj = 0; jj < 2; ++jj) { const int j = 2 * jp + jj;
                    const unsigned c0 = jj ? cw[i][jp].z : cw[i][jp].x, c1 = jj ? cw[i][jp].w : cw[i][jp].y, z0 = jj ? zw[i][jp].z : zw[i][jp].x, z1 = jj ? zw[i][jp].w : zw[i][jp].y;
                    const f32x4 g4 = *(const GAS f32x4*)(ng + col + 4 * jj), k4v = *(const GAS f32x4*)(skip + col + 4 * jj);
                    const float y0 = (acc[i][j][0] - mu) * rstd * g4.x + k4v.x * bflo(c0), y1 = (acc[i][j][1] - mu) * rstd * g4.y + k4v.y * bfhi(c0);
                    const float y2 = (acc[i][j][2] - mu) * rstd * g4.z + k4v.z * bflo(c1), y3 = (acc[i][j][3] - mu) * rstd * g4.w + k4v.w * bfhi(c1);
                    const unsigned o0 = pk2(y0 * bflo(z0), y1 * bfhi(z0)), o1 = pk2(y2 * bflo(z1), y3 * bfhi(z1));
                    if (jj == 0) { o.x = o0; o.y = o1; } else { o.z = o0; o.w = o1; } }
                *(GAS v4u*)(A2 + (size_t)(tok0 + t) * D + col) = o; } }
        __syncthreads();
    }
#undef P5_LOAD
}

__device__ __forceinline__ void build_dltab(Frame& F) {
    LAS float* dl = (LAS float*)(F.lds + EX_DL); const float* rb = F.in[I_RELBIAS];
    for (int idx = F.tid; idx < 4 * 640; idx += NWAVES * 64) {
        const int h = idx / 640, n = idx % 640 - 256; float v = 0.f;
        if (n < 0) v = -1.0e30f;
        else if (n < 128) {
            int bk;
            if (n < 16) bk = n; else { bk = 16 + (int)(logf((float)n / 16.0f) / 2.0794415416798357f * 16.0f); bk = bk > 31 ? 31 : bk; }
            v = (rb[bk * 4 + h] - rb[31 * 4 + h]) * LOG2E;
        }
        dl[idx] = v;
    }
}
__device__ __forceinline__ void p7_combine(Frame& F) {
    const bf16* AO = (const bf16*)F.out; bf16* A2 = (bf16*)((unsigned char*)F.out + OUT_A2);
    const float* lq = F.in[I_LAMQK]; const float* dg = F.in[I_DANORMG];
    const int lane = F.lane, gw = F.vcu * NWAVES + F.wave, NGW = F.G * NWAVES;
    const float sa = wave_sum(lq[lane] * lq[64 + lane]), sb = wave_sum(lq[128 + lane] * lq[192 + lane]);
    const float lam = __expf(sa) - __expf(sb) + LAM_INIT;
    const int dcol = (lane & 15) * 8;
    const f32x4 g0 = *(const GAS f32x4*)(dg + dcol), g1 = *(const GAS f32x4*)(dg + dcol + 4);
    for (int tok = gw; tok < M; tok += NGW) {
        const v4u a = *(const GAS v4u*)(AO + (size_t)tok * D + lane * 8), bb = *(const GAS v4u*)(AO + (size_t)tok * D + DH + lane * 8);
        float y[8];
        y[0] = bflo(a.x) - lam * bflo(bb.x); y[1] = bfhi(a.x) - lam * bfhi(bb.x); y[2] = bflo(a.y) - lam * bflo(bb.y); y[3] = bfhi(a.y) - lam * bfhi(bb.y);
        y[4] = bflo(a.z) - lam * bflo(bb.z); y[5] = bfhi(a.z) - lam * bfhi(bb.z); y[6] = bflo(a.w) - lam * bflo(bb.w); y[7] = bfhi(a.w) - lam * bfhi(bb.w);
        float ss = 0.f;
#pragma unroll
        for (int i = 0; i < 8; ++i) ss += y[i] * y[i];
        ss += __shfl_xor(ss, 1); ss += __shfl_xor(ss, 2); ss += __shfl_xor(ss, 4); ss += __shfl_xor(ss, 8);
        const float rs = (1.0f - LAM_INIT) / sqrtf(ss * (1.f / 128.f) + EPS_SUB);
        v4u o; o.x = pk2(y[0] * rs * g0.x, y[1] * rs * g0.y); o.y = pk2(y[2] * rs * g0.z, y[3] * rs * g0.w); o.z = pk2(y[4] * rs * g1.x, y[5] * rs * g1.y); o.w = pk2(y[6] * rs * g1.z, y[7] * rs * g1.w);
        *(GAS v4u*)(A2 + (size_t)tok * D + DH + lane * 8) = o;
    }
}
__device__ __forceinline__ void p9_router(Frame& F) {
    const bf16* X1B = (const bf16*)(F.ws + WS_X1B); float* RSROW = (float*)(F.ws + WS_RS); LAS float* sRS = (LAS float*)(F.lds + EX_SM);
    const float* brg = F.in[I_BRG]; const float* bre = F.in[I_BRE];
    int* EID = (int*)(F.ws + SM_EID); float* GATE = (float*)(F.ws + SM_GATE); int* POSR = (int*)(F.ws + SM_POS); int* ROWTOK = (int*)(F.ws + WS_RT);
    LAS int* lcnt = (LAS int*)(F.lds + EX_HIST); LAS int* lbase = lcnt + 32; LAS int* sE = (LAS int*)(F.lds + EX_ROW);
    const int lane = F.lane, gw = F.vcu * NWAVES + F.wave, NGW = F.G * NWAVES;
    LAS unsigned char* WL = F.lds; const bf16* WRT = (const bf16*)(F.ws + WS_WR);
    for (int c = F.tid; c < 48 * 128; c += NWAVES * 64) { const int p = c >> 7, ch = c & 127; *(LAS v4u*)(WL + p * 2048 + ((ch ^ (p & 15)) << 4)) = *(const GAS v4u*)(WRT + (size_t)p * D + ch * 8); }
    if (F.tid < 32) lcnt[F.tid] = 0;
    __syncthreads();
    for (int itx = 0; itx < F.rep9; ++itx) {
        const int ti = lane & 15, fq = lane >> 4, tok = gw + ti * NGW;
        const bf16* xrow = X1B + (size_t)tok * D + fq * 8;
        f32x4 acc[3]; acc[0] = (f32x4){0.f, 0.f, 0.f, 0.f}; acc[1] = acc[0]; acc[2] = acc[0]; float ss = 0.f;
#pragma unroll 8
        for (int ks = 0; ks < 32; ++ks) {
            const v4u aw = *(const GAS v4u*)(xrow + ks * 32); const bf16x8 a = __builtin_bit_cast(bf16x8, aw);
            ss += (bflo(aw.x) * bflo(aw.x) + bfhi(aw.x) * bfhi(aw.x)) + (bflo(aw.y) * bflo(aw.y) + bfhi(aw.y) * bfhi(aw.y)) + (bflo(aw.z) * bflo(aw.z) + bfhi(aw.z) * bfhi(aw.z)) + (bflo(aw.w) * bflo(aw.w) + bfhi(aw.w) * bfhi(aw.w));
#pragma unroll
            for (int j = 0; j < 3; ++j) { const int p = 16 * j + ti; const bf16x8 b = *(const LAS bf16x8*)(WL + p * 2048 + (((ks * 4 + fq) ^ (p & 15)) << 4)); acc[j] = __builtin_amdgcn_mfma_f32_16x16x32_bf16(b, a, acc[j], 0, 0, 0); }
        }
        ss += __shfl_xor(ss, 16); ss += __shfl_xor(ss, 32);
        const float rs = 1.0f / sqrtf(ss * (1.f / D) + EPS_RMS);
        const float lgm = acc[2][0] * rs + brg[fq];
        float mv = lgm; int mg = fq;
#pragma unroll
        for (int o = 16; o <= 32; o <<= 1) { const float ov = __shfl_xor(mv, o); const int og = __shfl_xor(mg, o); if (ov > mv || (ov == mv && og < mg)) { mv = ov; mg = og; } }
        float se = __expf(lgm - mv); se += __shfl_xor(se, 16); se += __shfl_xor(se, 32);
        if (fq == mg) {
            const float pgsel = 1.0f / se;
            float le[8];
#pragma unroll
            for (int e = 0; e < 8; ++e) le[e] = acc[e >> 2][e & 3] * rs + bre[fq * 8 + e];
            int i1 = 0; float v1 = le[0];
#pragma unroll
            for (int i = 1; i < 8; ++i) if (le[i] > v1) { v1 = le[i]; i1 = i; }
            int i2 = -1; float v2 = -INFINITY;
#pragma unroll
            for (int i = 0; i < 8; ++i) if (i != i1 && le[i] > v2) { v2 = le[i]; i2 = i; }
            const float p1 = 1.0f / (1.0f + __expf(v2 - v1)), p2 = 1.0f - p1;
            const int lt = F.wave * 16 + ti; sE[lt * 2] = fq * 8 + i1; sE[lt * 2 + 1] = fq * 8 + i2; sRS[lt] = rs; GATE[(size_t)tok * 2] = pgsel * p1; GATE[(size_t)tok * 2 + 1] = pgsel * p2;
        }
    }
    __syncthreads();
    int e = 0, rank = 0;
    if (F.tid < 256) { e = sE[F.tid]; rank = __hip_atomic_fetch_add(lcnt + e, 1, __ATOMIC_RELAXED, __HIP_MEMORY_SCOPE_WORKGROUP); }
    __syncthreads();
    if (F.tid < 32) lbase[F.tid] = (int)__hip_atomic_fetch_add(F.ctl + CW_CUR + F.tid, (unsigned)lcnt[F.tid], RLX_AGENT);
    __syncthreads();
    if (F.tid < 256) { const int lt = F.tid >> 1, tok = F.vcu * NWAVES + (lt >> 4) + (lt & 15) * NGW, r = lbase[e] + rank;
        EID[(size_t)tok * 2 + (F.tid & 1)] = e; POSR[(size_t)tok * 2 + (F.tid & 1)] = r; ROWTOK[(size_t)e * RT_CAP + r] = tok; RSROW[(size_t)e * RT_CAP + r] = sRS[lt]; }
}
__device__ __forceinline__ void build_offsets(Frame& F) {
    LAS int* off = (LAS int*)(F.lds + EX_OFF); LAS int* cntl = (LAS int*)(F.lds + EX_CNT); LAS int* te = (LAS int*)(F.lds + EX_TE);
    if (F.wave == 0) {
        const int lane = F.lane; const int c = lane < 32 ? (int)__hip_atomic_load(F.ctl + CW_CUR + lane, RLX_AGENT) : 0;
        const int tiles = (c + 255) >> 8; int incl = tiles;
#pragma unroll
        for (int o = 1; o < 64; o <<= 1) { const int y = __shfl_up(incl, o); if (lane >= o) incl += y; }
        if (lane < 32) { off[lane + 1] = incl * 256; cntl[lane] = c; } if (lane == 0) off[0] = 0;
    }
    __syncthreads();
    for (int pm = F.tid; pm < MAXT; pm += NWAVES * 64) { int e = 0;
        for (int k = 1; k < 32; ++k) if (pm * 256 >= off[k]) e = k;
        te[pm] = e; }
    __syncthreads();
}
__device__ __forceinline__ void p13_final(Frame& F, bool with_moe) {
    float* outp = F.out; const bf16* X1B = (const bf16*)(F.ws + WS_X1B); const unsigned char* Y = (const unsigned char*)(F.ws + WS_Y)  ; const int* POSR = (const int*)(F.ws + SM_POS); const int* EID = (const int*)(F.ws + SM_EID); const float* GATE = (const float*)(F.ws + SM_GATE);
    const float* gf = F.in[I_NORMFG]; const LAS int* off = (const LAS int*)(F.lds + EX_OFF);
    const int lane = F.lane, gw = F.vcu * NWAVES + F.wave, NGW = F.G * NWAVES;
    f32x4 gg[4];
#pragma unroll
    for (int j = 0; j < 4; ++j) gg[j] = ((const GAS f32x4*)gf + lane)[64 * j];
    for (int tok0 = gw; tok0 < M; tok0 += 4 * NGW) {
        f32x4 v[4][4]; unsigned ya[4][4], yb[4][4]; float q0[4], q1[4];
#pragma unroll
        for (int q = 0; q < 4; ++q) { const int tok = tok0 + q * NGW; const bool ok = tok < M; const int tk = ok ? tok : 0;
            const GAS v2u* xr = (const GAS v2u*)(X1B + (size_t)tk * D) + lane;
#pragma unroll
            for (int j = 0; j < 4; ++j) { const v2u w = xr[64 * j]; v[q][j] = (f32x4){bflo(w.x), bfhi(w.x), bflo(w.y), bfhi(w.y)}; }
            if (with_moe) {
                const int p0 = off[EID[(size_t)tk * 2]] + POSR[(size_t)tk * 2], p1 = off[EID[(size_t)tk * 2 + 1]] + POSR[(size_t)tk * 2 + 1]; q0[q] = GATE[(size_t)tk * 2]; q1[q] = GATE[(size_t)tk * 2 + 1];
                const GAS unsigned* y0 = (const GAS unsigned*)(Y + (size_t)p0 * D) + lane; const GAS unsigned* y1 = (const GAS unsigned*)(Y + (size_t)p1 * D) + lane;
#pragma unroll
                for (int j = 0; j < 4; ++j) { ya[q][j] = y0[64 * j]; yb[q][j] = y1[64 * j]; }
            }
        }
#pragma unroll
        for (int q = 0; q < 4; ++q) { const int tok = tok0 + q * NGW; if (tok >= M) break;
            if (with_moe) {
#pragma unroll
                for (int j = 0; j < 4; ++j) { typedef float f32x2_ __attribute__((ext_vector_type(2)));
                    const f32x2_ a0 = __builtin_amdgcn_cvt_pk_f32_fp8((int)ya[q][j], false), a1 = __builtin_amdgcn_cvt_pk_f32_fp8((int)ya[q][j], true), b0 = __builtin_amdgcn_cvt_pk_f32_fp8((int)yb[q][j], false), b1 = __builtin_amdgcn_cvt_pk_f32_fp8((int)yb[q][j], true);
                    v[q][j].x += q0[q] * a0.x + q1[q] * b0.x; v[q][j].y += q0[q] * a0.y + q1[q] * b0.y; v[q][j].z += q0[q] * a1.x + q1[q] * b1.x; v[q][j].w += q0[q] * a1.y + q1[q] * b1.y; }
            }
            float s = 0.f;
#pragma unroll
            for (int j = 0; j < 4; ++j) s += (v[q][j].x * v[q][j].x + v[q][j].y * v[q][j].y) + (v[q][j].z * v[q][j].z + v[q][j].w * v[q][j].w);
            const float rs = 1.0f / sqrtf(wave_sum(s) * (1.f / D) + EPS_RMS);
            GAS f32x4* xw = (GAS f32x4*)(outp + (size_t)tok * D) + lane;
#pragma unroll
            for (int j = 0; j < 4; ++j) { f32x4 o; o.x = v[q][j].x * rs * gg[j].x; o.y = v[q][j].y * rs * gg[j].y; o.z = v[q][j].z * rs * gg[j].z; o.w = v[q][j].w * rs * gg[j].w; xw[64 * j] = o; }
        }
    }
}
__device__ __forceinline__ void copy_x_to_out(Frame& F) {
    const int gt = (F.vcu * NWAVES + F.wave) * 64 + F.lane, NT = F.G * NWAVES * 64;
    const GAS f32x4* s = (const GAS f32x4*)F.in[I_X]; GAS v2u* d = (GAS v2u*)(F.ws + WS_X1B);
    for (size_t i = gt; i < (size_t)M * D / 4; i += NT) { const f32x4 v = s[i]; v2u o; o.x = pk2(v.x, v.y); o.y = pk2(v.z, v.w); d[i] = o; }
}

#ifndef EN_MIX_D
#define EN_MIX_D 1
#endif
#ifndef EN_MIX_M
#define EN_MIX_M 1
#endif
#ifndef EN_MOE
#define EN_MOE 1
#endif
constexpr int N_PHASES = 14;
struct Args { const float* in[24]; float* out; unsigned char* ws; int ph_lo, ph_hi, rep_mask, pad; };
__global__ void __launch_bounds__(NWAVES * 64, 2) fwd_kernel(Args args) {
    extern __shared__ __attribute__((aligned(16))) unsigned char lds[];
    Frame F;
    F.lds = (LAS unsigned char*)lds;
    F.MISC = (volatile LAS unsigned*)(F.lds + MISC_OFF);
    F.tid = threadIdx.x; F.lane = F.tid & 63; F.wave = __builtin_amdgcn_readfirstlane(F.tid >> 6);
    F.G = gridDim.x; { const int bx = blockIdx.x; F.vcu = (F.G % 8 == 0) ? (bx % 8) * (F.G / 8) + bx / 8 : bx; }
    F.ws = args.ws; F.ctl = (gu32*)(args.ws + WS_CTL); F.out = args.out; F.rep9 = REPS(9);
#pragma unroll
    for (int i = 0; i < 24; ++i) F.in[i] = args.in[i];
    for (int u = F.tid; u < 128; u += NWAVES * 64) ((LAS unsigned*)(F.lds + LDSCTL_OFF))[u] = 0u;
    __syncthreads();
    XcdBarrier bar; bar.bar = (unsigned*)(F.ctl + CW_BAR); bar.x = 0; bar.st = nullptr;
    if (!MK_PER_PHASE) bar = xcd_barrier_post((unsigned*)(F.ctl + CW_BAR), F.MISC + 8);
    const int lo = args.ph_lo, hi = args.ph_hi;
#define IN(k) (lo <= (k) && (k) < hi)
#ifndef SEAM_REP
#define SEAM_REP 1
#endif
#define SEAM(k) do { if (IN(k) && IN((k) + 1)) { for (int sr_ = 0; sr_ < SEAM_REP; ++sr_) xcd_barrier(bar); } } while (0)
    unsigned char* ws = args.ws;

    if (IN(0)) { for (int rp = 0; rp < REPS(0); ++rp) p0_prologue(F); } SEAM(0);
    if (IN(1) && (EN_MIX_D || EN_MIX_M)) for (int rp = 0; rp < REPS(1); ++rp) {
        pg8::Gemm g{(const pg8::bf16_t*)(ws + WS_HB), (const pg8::bf16_t*)(ws + WS_WIN), M, NPROJ, D, 0}; pg8::StaticOrder S; S.init(M, NPROJ, F.G, (int)blockIdx.x);
        pg8::EpiBf16S E{(pg8::bf16_t*)(ws + WS_PC), DH, DH, (size_t)(WS_PV - WS_PC) / 2, 3, attn_body::C2, 2};
        pg8::gemm_phase<pg8::EpiBf16S, pg8::StaticOrder, PG8_ALIGN, PG8_SP2>(F.lds + RING_OFF, g, S, E);
    } SEAM(1);
    if (IN(2) && EN_MIX_M) { for (int rp = 0; rp < REPS(2); ++rp) p2_mfront(F); }
    if (IN(3) && EN_MIX_M) { for (int rp = 0; rp < REPS(3); ++rp) p3_mlocal(F); } SEAM(3);
    if (IN(4) && EN_MIX_M) { for (int rp = 0; rp < REPS(4); ++rp) p4_mscan(F); } SEAM(4);
    if (IN(5)) { if (EN_MIX_M) { for (int rp = 0; rp < REPS(5); ++rp) p5_mout(F); } else { bf16* A2 = (bf16*)((unsigned char*)F.out + OUT_A2); const int gt = (F.vcu * NWAVES + F.wave) * 64 + F.lane;
            for (size_t i = gt; i < (size_t)M * 64; i += (size_t)F.G * NWAVES * 64) { const size_t tok = i >> 6, c = i & 63; *(GAS v4u*)(A2 + tok * D + c * 8) = (v4u){0u, 0u, 0u, 0u}; } } }
    if (IN(6) && EN_MIX_D) for (int rp = 0; rp < REPS(6); ++rp) {
        const bool conv_first = (((int)blockIdx.x >> 3) & 1) == 0;
        if (EN_MOE && conv_first) { for (int rc_ = 0; rc_ < PROBE_CONVREP; ++rc_) { p_expert_weights(F); __syncthreads(); } }
        build_dltab(F); __syncthreads();
        const attn_body::AttnTensors AT{(const attn_body::bf16*)(ws + WS_PQ), (const attn_body::bf16*)(ws + WS_PK), (const attn_body::bf16*)(ws + WS_PVD), (attn_body::bf16*)F.out};
        const attn_body::StaticOrder S((int)F.G, (int)blockIdx.x);
        attn_body::attn_phase<attn_body::StaticOrder>((char*)lds + RING_OFF, AT, S, (const LAS float*)(F.lds + EX_DL));
        if (EN_MOE && !conv_first) { for (int rc_ = 0; rc_ < PROBE_CONVREP; ++rc_) { __syncthreads(); p_expert_weights(F); } }
    } SEAM(6);
    if (IN(7)) { if (EN_MIX_D) { for (int rp = 0; rp < REPS(7); ++rp) p7_combine(F); } else { bf16* A2 = (bf16*)((unsigned char*)F.out + OUT_A2); const int gt = (F.vcu * NWAVES + F.wave) * 64 + F.lane;
            for (size_t i = gt; i < (size_t)M * 64; i += (size_t)F.G * NWAVES * 64) { const size_t tok = i >> 6, c = i & 63; *(GAS v4u*)(A2 + tok * D + DH + c * 8) = (v4u){0u, 0u, 0u, 0u}; } } } SEAM(7);
    if (IN(8)) for (int rp = 0; rp < REPS(8); ++rp) {
        if (EN_MIX_D || EN_MIX_M) {
            pg8::Gemm g{(const pg8::bf16_t*)((unsigned char*)F.out + OUT_A2), (const pg8::bf16_t*)(ws + WS_WOUT), M, D, D, 0}; pg8::StaticOrder S; S.init(M, D, F.G, (int)blockIdx.x);
            pg8::EpiResBf16 E{(const pg8::bf16_t*)(ws + WS_HB), (const float*)(ws + SM_RMS1), (pg8::bf16_t*)(ws + WS_X1B), D, (unsigned char*)(ws + WS_X1F8)};
            pg8::gemm_phase<pg8::EpiResBf16, pg8::StaticOrder, PG8_ALIGN, PG8_SP2>(F.lds + RING_OFF, g, S, E);
        } else copy_x_to_out(F);
    } SEAM(8);
    if (IN(9) && EN_MOE) { p9_router(F); } SEAM(9);
    if (IN(10) && EN_MOE) { build_offsets(F); }
    if (IN(11) && EN_MOE) for (int rp = 0; rp < REPS(11); ++rp) {
        if (MK_PER_PHASE || !(IN(10))) build_offsets(F);
        const int T = ((LAS int*)(F.lds + EX_OFF))[32] >> 8;
        pg8::Gemm g{(const pg8::bf16_t*)(ws + WS_X1F8), (const pg8::bf16_t*)(ws + WS_WGU), T * 256, D, D, (size_t)D * D}; pg8::GroupedOrder S; S.init(T, D, F.G, (int)blockIdx.x, (const LAS int*)(F.lds + EX_TE));
        pg8::EpiSwiGLU E{(unsigned char*)(ws + WS_HID), FFE, (const float*)(ws + WS_RS), (const LAS int*)(F.lds + EX_OFF), RT_CAP};
        pg8::RowGather GT{(const int*)(ws + WS_RT), (const LAS int*)(F.lds + EX_OFF), (const LAS int*)(F.lds + EX_CNT), RT_CAP};
        pg8::gemm_phase<pg8::EpiSwiGLU, pg8::GroupedOrder, PG8_ALIGN, PG8_SP2, pg8::RowGather, true>(F.lds + RING_OFF, g, S, E, GT);
    } SEAM(11);
    if (IN(12) && EN_MOE) for (int rp = 0; rp < REPS(12); ++rp) {
        if (MK_PER_PHASE || !(IN(10))) build_offsets(F);
        const int T = ((LAS int*)(F.lds + EX_OFF))[32] >> 8;
        pg8::Gemm g{(const pg8::bf16_t*)(ws + WS_HID), (const pg8::bf16_t*)(ws + WS_WD), T * 256, D, FFE, (size_t)D * FFE}; pg8::GroupedOrder S; S.init(T, D, F.G, (int)blockIdx.x, (const LAS int*)(F.lds + EX_TE));
        pg8::EpiFp8 E{(unsigned char*)(ws + WS_Y), D};
#ifdef PROBE_NOSTORE12
        E.nostore = rp;
#endif
        pg8::gemm_phase<pg8::EpiFp8, pg8::GroupedOrder, PG8_ALIGN, PG8_SP2, pg8::NoGather, true>(F.lds + RING_OFF, g, S, E);
    } SEAM(12);
    if (IN(13)) { if (EN_MOE && (MK_PER_PHASE || !(IN(10)))) build_offsets(F); p13_final(F, EN_MOE != 0); }
#undef IN
#undef SEAM
}

extern "C" void kernel_launch(void* const* d_in, const int* in_sizes, int n_in, void* d_out, int out_size, void* d_ws, size_t ws_size, hipStream_t stream) {
    static int grid = 0;
    if (grid == 0) {
        if (n_in != 24 || in_sizes[0] != M * D || out_size != M * D || ws_size < WS_END) { fprintf(stderr, "kernel_launch: unexpected shapes (n_in %d, in0 %d, out %d, ws %zu); nothing launched\n", n_in, n_in > 0 ? in_sizes[0] : -1, out_size, ws_size); grid = -1; return; }
        int dev = 0, cus = 0, per_cu = 0;
        if (hipGetDevice(&dev) != hipSuccess || hipDeviceGetAttribute(&cus, hipDeviceAttributeMultiprocessorCount, dev) != hipSuccess) { grid = -1; return; }
        if (hipFuncSetAttribute((const void*)fwd_kernel, hipFuncAttributeMaxDynamicSharedMemorySize, LDS_BYTES) != hipSuccess) { fprintf(stderr, "kernel_launch: hipFuncSetAttribute failed\n"); grid = -1; return; }
        if (hipOccupancyMaxActiveBlocksPerMultiprocessor(&per_cu, (const void*)fwd_kernel, NWAVES * 64, LDS_BYTES) != hipSuccess || per_cu < 1) fprintf(stderr, "kernel_launch: occupancy query reports %d\n", per_cu);
        (void)hipGetLastError();
        grid = cus;
    }
    if (grid < 0) return;
    if (hipMemsetAsync((char*)d_ws + WS_CTL, 0, CTL_ZERO_BYTES, stream) != hipSuccess) return;
    Args a{};
    for (int i = 0; i < 24; ++i) a.in[i] = (const float*)d_in[i];
    a.out = (float*)d_out; a.ws = (unsigned char*)d_ws; a.rep_mask = REP_MASK; a.pad = 0;
#if MK_PER_PHASE
    for (int p = 0; p < N_PHASES; ++p) { a.ph_lo = p; a.ph_hi = p + 1; hipLaunchKernelGGL(fwd_kernel, dim3(grid), dim3(NWAVES * 64), LDS_BYTES, stream, a); }
#else
    a.ph_lo = 0; a.ph_hi = N_PHASES;
    hipLaunchKernelGGL(fwd_kernel, dim3(grid), dim3(NWAVES * 64), LDS_BYTES, stream, a);
#endif
}
```

```cpp
#define EN_MIX_D 1
#define EN_MIX_M 1
#define EN_MOE 1
#include <hip/hip_runtime.h>
#include <cstdio>
#include <cstdint>
#ifndef PROBE_CONVREP
#define PROBE_CONVREP 1
#endif
#ifndef REP_MASK
#define REP_MASK 0
#endif
#define REPS(k) (((REP_MASK >> (k)) & 1) ? (((args.rep_mask >> (k)) & 1) + 1) : 1)

#ifndef PEW_SH
#define PEW_SH 2
#endif
#ifndef PEW_S7
#define PEW_S7 2
#endif
#ifndef PROBE_NT_FROM
#define PROBE_NT_FROM 6
#endif
namespace pg8 {
#define PG8_LAS __attribute__((address_space(3)))
typedef unsigned short bf16_t;
typedef short bf16x8 __attribute__((ext_vector_type(8)));
typedef float f32x4 __attribute__((ext_vector_type(4)));
typedef unsigned u32x4 __attribute__((ext_vector_type(4)));
constexpr int BM = 256, BK = 64, HALF = 128, HTB = HALF * BK * 2  , STAGE_BYTES = 8 * HTB, NXCD = 8, WGM = 8;

__host__ __device__ __forceinline__ int lds_byte(int r, int c) { const int st = (r >> 4) * 2 + (c >> 5), rr = r & 15, cc = c & 31, ob = rr * 64 + cc * 2; return st * 1024 + (ob ^ (((ob >> 9) & 1) << 5)); }
__host__ __device__ __forceinline__ void stage_rc(int b, int& R, int& C) { const int st = b / 1024, sb = b % 1024, swz = sb ^ (((sb >> 9) & 1) << 5); R = (st >> 1) * 16 + swz / 64; C = (st & 1) * 32 + (swz % 64) / 2; }
__host__ __device__ __forceinline__ int perm32(int rho) { const int n = rho >> 4, i = rho & 15; return 8 * (i >> 2) + 4 * n + (i & 3); }

struct Unit { int pm, pn, e; };
struct Gemm { const bf16_t* A; const bf16_t* Bt; int M, N, K; size_t bstride; };

struct StaticOrder {
    int nM, nN, nwg, G, c;
    __host__ __device__ void init(int M, int N, int G_, int c_) { nM = M / BM; nN = N / BM; nwg = nM * nN; G = G_; c = c_; }
    __host__ __device__ bool next(int i, Unit& u) const {
        const long L = (long)i * G + c; if (L >= nwg) return false;
        int wgid = (int)L; { const int q = nwg / NXCD, r = nwg % NXCD, xcd = wgid % NXCD, off = wgid / NXCD; wgid = (xcd < r ? xcd * (q + 1) : r * (q + 1) + (xcd - r) * q) + off; }
        const int nig = WGM * nN, gid = wgid / nig, fm = gid * WGM, gsz = (nM - fm) < WGM ? (nM - fm) : WGM;
        u.pm = fm + ((wgid % nig) % gsz); u.pn = (wgid % nig) / gsz; u.e = 0; return true;
    }
    __device__ __forceinline__ void a_ready(const Unit&) const {}
    __device__ __forceinline__ void done(const Unit&) const {}
};


struct GroupedOrder {
    int nM, nN, nwg, G, c; const PG8_LAS int* tile_e;
    __device__ void init(int nM_, int N, int G_, int c_, const PG8_LAS int* te) { nM = nM_; nN = N / BM; nwg = nM * nN; G = G_; c = c_; tile_e = te; }
    __device__ bool next(int i, Unit& u) const {
        const long L = (long)i * G + c; if (L >= nwg) return false;
        int wgid = (int)L; { const int q = nwg / NXCD, r = nwg % NXCD, xcd = wgid % NXCD, off = wgid / NXCD; wgid = (xcd < r ? xcd * (q + 1) : r * (q + 1) + (xcd - r) * q) + off; }
        const int nig = WGM * nN, gid = wgid / nig, fm = gid * WGM, gsz = (nM - fm) < WGM ? (nM - fm) : WGM;
        u.pm = fm + ((wgid % nig) % gsz); u.pn = (wgid % nig) / gsz; u.e = __builtin_amdgcn_readfirstlane(tile_e[u.pm]); return true;
    }
    __device__ __forceinline__ void a_ready(const Unit&) const {}
    __device__ __forceinline__ void done(const Unit&) const {}
};

__device__ __forceinline__ unsigned cvt_pk_bf16(float lo, float hi) { unsigned r; asm volatile("v_cvt_pk_bf16_f32 %0, %1, %2" : "=v"(r) : "v"(lo), "v"(hi)); return r; }

__device__ __forceinline__ void pack_fp8x8(const float (&v)[8], unsigned& lo, unsigned& hi) {
    int a = 0, b = 0; a = __builtin_amdgcn_cvt_pk_fp8_f32(v[0], v[1], a, false); a = __builtin_amdgcn_cvt_pk_fp8_f32(v[2], v[3], a, true);
    b = __builtin_amdgcn_cvt_pk_fp8_f32(v[4], v[5], b, false); b = __builtin_amdgcn_cvt_pk_fp8_f32(v[6], v[7], b, true); lo = (unsigned)a; hi = (unsigned)b; }
typedef unsigned u32x2 __attribute__((ext_vector_type(2)));
struct EpiBf16S {
    static constexpr bool PERM = true, AFTER_DRAIN = false, WIDE = true, HAS_PRE = false;
    bf16_t* O; int ldc; int split_cols; size_t split_stride; int scale_tile; float scale0; int sig_tile; int nt_from; int tk, tadd;
    static __device__ __forceinline__ u32x4 xch(u32x4 v) { u32x4 r; r.x = (unsigned)__builtin_amdgcn_mov_dpp((int)v.x, 0xB1, 0xF, 0xF, true); r.y = (unsigned)__builtin_amdgcn_mov_dpp((int)v.y, 0xB1, 0xF, 0xF, true);
        r.z = (unsigned)__builtin_amdgcn_mov_dpp((int)v.z, 0xB1, 0xF, 0xF, true); r.w = (unsigned)__builtin_amdgcn_mov_dpp((int)v.w, 0xB1, 0xF, 0xF, true); return r; }
    __device__ __forceinline__ void operator()(const f32x4 (&acc)[2][2][4][2], const Unit& u, int wr, int wc, int fr, int fq) const {
        int colt = u.pn * BM; bf16_t* base = O; bool sig = false, nt = false;
        float sc = 1.f; if (split_cols) { const int t0 = colt / split_cols, t = t0 + (t0 >= tk ? tadd : 0); base += (size_t)t * split_stride; colt -= t0 * split_cols; if (t == scale_tile) sc = scale0; sig = (t == sig_tile); nt = (t >= nt_from); }
        const bool odd = fr & 1; const int row0 = u.pm * BM + wr * 64, col0 = colt + wc * 64 + 16 * fq + (odd ? 8 : 0);
#pragma unroll
        for (int ai = 0; ai < 2; ++ai)
#pragma unroll
            for (int m = 0; m < 4; ++m) { const int rb = row0 + ai * HALF + m * 16; u32x4 wv[2];
#pragma unroll
                for (int bj = 0; bj < 2; ++bj) { f32x4 v0 = acc[ai][bj][m][0] * sc, v1 = acc[ai][bj][m][1] * sc;
                    if (sig) { _Pragma("unroll") for (int i_ = 0; i_ < 4; ++i_) { v0[i_] = __builtin_amdgcn_rcpf(1.0f + __builtin_amdgcn_exp2f(-1.4426950408889634f * v0[i_])); v1[i_] = __builtin_amdgcn_rcpf(1.0f + __builtin_amdgcn_exp2f(-1.4426950408889634f * v1[i_])); } }
                    u32x4 w; w.x = cvt_pk_bf16(v0[0], v0[1]); w.y = cvt_pk_bf16(v0[2], v0[3]); w.z = cvt_pk_bf16(v1[0], v1[1]); w.w = cvt_pk_bf16(v1[2], v1[3]); wv[bj] = w; }
                const u32x4 snd = xch(odd ? wv[0] : wv[1]); const u32x4 sa = odd ? snd : wv[0], sb = odd ? wv[1] : snd;
                u32x4* pa = (u32x4*)(base + (size_t)(rb + (fr & ~1)) * ldc + col0); u32x4* pb = (u32x4*)(base + (size_t)(rb + (fr | 1)) * ldc + col0);
                if (nt) { __builtin_nontemporal_store(sa, pa); __builtin_nontemporal_store(sb, pb); } else { *pa = sa; *pb = sb; } }
    }
};
struct EpiFp8 {
    static constexpr bool PERM = true, AFTER_DRAIN = false, WIDE = true, HAS_PRE = false;
    unsigned char* O; int ldc; int nostore = 0;
    __device__ __forceinline__ void operator()(const f32x4 (&acc)[2][2][4][2], const Unit& u, int wr, int wc, int fr, int fq) const {
        const int row0 = u.pm * BM + wr * 64 + fr, col0 = u.pn * BM + wc * 64 + 16 * fq;
#pragma unroll
        for (int ai = 0; ai < 2; ++ai)
#pragma unroll
            for (int m = 0; m < 4; ++m) { unsigned char* rowp = O + (size_t)(row0 + ai * HALF + m * 16) * ldc + col0; u32x4 q;
#pragma unroll
                for (int bj = 0; bj < 2; ++bj) { const f32x4 v0 = acc[ai][bj][m][0], v1 = acc[ai][bj][m][1];
                    const float f8v[8] = {v0[0], v0[1], v0[2], v0[3], v1[0], v1[1], v1[2], v1[3]}; unsigned q0, q1; pack_fp8x8(f8v, q0, q1); if (bj == 0) { q.x = q0; q.y = q1; } else { q.z = q0; q.w = q1; } }
                if (!nostore) *(u32x4*)rowp = q; else asm volatile("" :: "v"(q.x), "v"(q.y), "v"(q.z), "v"(q.w)); }
    }
};
struct EpiResF32 {
    static constexpr bool PERM = false, AFTER_DRAIN = false, WIDE = false, HAS_PRE = false;
    const float* base; float* out; int ldc;
    __device__ __forceinline__ void operator()(const f32x4 (&acc)[2][2][4][2], const Unit& u, int wr, int wc, int fr, int fq) const {
        const int row0 = u.pm * BM + wr * 64 + fr, col0 = u.pn * BM + wc * 32 + 4 * fq;
#pragma unroll
        for (int ai = 0; ai < 2; ++ai)
#pragma unroll
            for (int m = 0; m < 4; ++m) { const size_t off = (size_t)(row0 + ai * HALF + m * 16) * ldc + col0;
#pragma unroll
                for (int bj = 0; bj < 2; ++bj)
#pragma unroll
                    for (int n = 0; n < 2; ++n) { const f32x4 b = *(const f32x4*)(base + off + bj * HALF + n * 16); *(f32x4*)(out + off + bj * HALF + n * 16) = b + acc[ai][bj][m][n]; } }
    }
};
struct EpiResBf16 {
    static constexpr bool PERM = true, AFTER_DRAIN = false, WIDE = true, HAS_PRE = false;
    const bf16_t* base; const float* rms; bf16_t* out; int ldc; unsigned char* out8;
    __device__ __forceinline__ void operator()(const f32x4 (&acc)[2][2][4][2], const Unit& u, int wr, int wc, int fr, int fq) const {
        const int row0 = u.pm * BM + wr * 64 + fr, col0 = u.pn * BM + wc * 64 + 16 * fq;
#pragma unroll
        for (int ai = 0; ai < 2; ++ai)
#pragma unroll
            for (int m = 0; m < 4; ++m) { const size_t off = (size_t)(row0 + ai * HALF + m * 16) * ldc + col0; const float rr = rms[row0 + ai * HALF + m * 16];
                const u32x4 hb0 = *(const u32x4*)(base + off), hb1 = *(const u32x4*)(base + off + 8); u32x4 q;
#pragma unroll
                for (int bj = 0; bj < 2; ++bj) { const u32x4 hb = bj ? hb1 : hb0;
                    const f32x4 b0 = (f32x4){__builtin_bit_cast(float, hb.x << 16), __builtin_bit_cast(float, hb.x & 0xffff0000u), __builtin_bit_cast(float, hb.y << 16), __builtin_bit_cast(float, hb.y & 0xffff0000u)} * rr;
                    const f32x4 b1 = (f32x4){__builtin_bit_cast(float, hb.z << 16), __builtin_bit_cast(float, hb.z & 0xffff0000u), __builtin_bit_cast(float, hb.w << 16), __builtin_bit_cast(float, hb.w & 0xffff0000u)} * rr;
                    const f32x4 v0 = acc[ai][bj][m][0] + b0, v1 = acc[ai][bj][m][1] + b1;
                    u32x4 w; w.x = cvt_pk_bf16(v0[0], v0[1]); w.y = cvt_pk_bf16(v0[2], v0[3]); w.z = cvt_pk_bf16(v1[0], v1[1]); w.w = cvt_pk_bf16(v1[2], v1[3]);
                    *(u32x4*)(out + off + bj * 8) = w;
                    { const float f8v[8] = {v0[0], v0[1], v0[2], v0[3], v1[0], v1[1], v1[2], v1[3]}; unsigned q0, q1; pack_fp8x8(f8v, q0, q1); if (bj == 0) { q.x = q0; q.y = q1; } else { q.z = q0; q.w = q1; } } }
                *(u32x4*)(out8 + off) = q; }
    }
};
struct EpiSwiGLU {
    static constexpr bool PERM = true, AFTER_DRAIN = false, WIDE = false, HAS_PRE = true;
    unsigned char* O; int ldc; const float* rsrow; const PG8_LAS int* off; int cap;
    __device__ __forceinline__ float sg(float g, float up) const { return g * up * __builtin_amdgcn_rcpf(1.0f + __builtin_amdgcn_exp2f(-1.4426950408889634f * g)); }
    __device__ __forceinline__ void prefetch(const Unit& u, int wr, int fr, float (&rs)[2][4]) const {
        const float* rsl = rsrow + (size_t)u.e * cap + (u.pm * BM - off[u.e]) + wr * 64 + fr;
#pragma unroll
        for (int ai = 0; ai < 2; ++ai)
#pragma unroll
            for (int m = 0; m < 4; ++m) rs[ai][m] = rsl[ai * HALF + m * 16];
    }
    __device__ __forceinline__ void operator()(const f32x4 (&acc)[2][2][4][2], const Unit& u, int wr, int wc, int fr, int fq, const float (&rs)[2][4]) const {
        const int row0 = u.pm * BM + wr * 64 + fr;
        unsigned char* colp = O + (size_t)row0 * ldc + u.pn * HALF + wc * 32 + 8 * (fq & ~1);
#pragma unroll
        for (int ai = 0; ai < 2; ++ai)
#pragma unroll
            for (int mp = 0; mp < 2; ++mp) { unsigned qq[2][2];
#pragma unroll
                for (int k = 0; k < 2; ++k) { const int m = 2 * mp + k; const float r = rs[ai][m];
                    const f32x4 g0 = acc[ai][0][m][0] * r, g1 = acc[ai][0][m][1] * r, u0 = acc[ai][1][m][0] * r, u1 = acc[ai][1][m][1] * r;
                    const float hv[8] = {sg(g0[0], u0[0]), sg(g0[1], u0[1]), sg(g0[2], u0[2]), sg(g0[3], u0[3]), sg(g1[0], u1[0]), sg(g1[1], u1[1]), sg(g1[2], u1[2]), sg(g1[3], u1[3])};
                    pack_fp8x8(hv, qq[k][0], qq[k][1]); }
                const auto s0 = __builtin_amdgcn_permlane16_swap(qq[0][0], qq[1][0], false, false), s1 = __builtin_amdgcn_permlane16_swap(qq[0][1], qq[1][1], false, false);
                u32x4 q; q.x = s0[0]; q.y = s1[0]; q.z = s0[1]; q.w = s1[1];
                *(u32x4*)(colp + (size_t)(ai * HALF + (2 * mp + (fq & 1)) * 16) * ldc) = q; }
    }
};

struct NoGather { static constexpr bool ON = false; };
struct RowGather { static constexpr bool ON = true; const int* rowtok; const PG8_LAS int* off; const PG8_LAS int* cnt; int cap;
    __device__ __forceinline__ unsigned rowoff(const Unit& u, int lr, int pitch) const { const int rr = u.pm * BM - off[u.e] + lr, cm = cnt[u.e] - 1; const int tok = rowtok[(size_t)u.e * cap + (rr < cm ? rr : cm)]; return (unsigned)tok * (unsigned)pitch; } };

typedef int v8i32 __attribute__((ext_vector_type(8))); typedef short s16x16 __attribute__((ext_vector_type(16)));
__device__ __forceinline__ v8i32 cat16(bf16x8 lo, bf16x8 hi) { const s16x16 t = __builtin_shufflevector(lo, hi, 0, 1, 2, 3, 4, 5, 6, 7, 8, 9, 10, 11, 12, 13, 14, 15); return __builtin_bit_cast(v8i32, t); }
template <class Epi, class Sched, bool ALIGN_EPI = false, bool SP2 = false, class Gt = NoGather, bool F8 = false>
__device__ __forceinline__ void gemm_phase(PG8_LAS unsigned char* lds, const Gemm g, const Sched& S, const Epi& E, const Gt& GT = Gt()) {
    const int tid = threadIdx.x, wid = __builtin_amdgcn_readfirstlane(tid >> 6), lane = tid & 63, wr = wid >> 2, wc = wid & 3, fr = lane & 15, fq = lane >> 4;
    const int K = g.K, P = F8 ? K : 2 * K  , nt = P / (BK * 2); constexpr int KSTR = 1024;
    unsigned voffA[2], voffB[2];
#pragma unroll
    for (int i = 0; i < 2; ++i) { int R, C; stage_rc(tid * 16 + i * 8192, R, C); const int Rb = Epi::WIDE ? (64 * (R >> 5) + 16 * ((R & 15) >> 2) + 4 * ((R >> 4) & 1) + (R & 3)) : Epi::PERM ? ((R & ~31) + perm32(R & 31)) : R;
        voffA[i] = (unsigned)(R * P + C * 2); voffB[i] = (unsigned)(Rb * P + C * 2); }
    const size_t kstep = (size_t)(BK * 2);
    const size_t hstep = (size_t)HALF * P;
    const size_t bstep = Epi::WIDE ? (size_t)8 * P : hstep;
    const size_t tstep = 2 * hstep;
    const unsigned ldsw = (unsigned)wid * 1024u;
    const int aoff = lds_byte(wr * 64 + fr, fq * 8), boff = lds_byte(wc * 32 + fr, fq * 8);
#define PG8_SA(b, h) (((b) * 2 + (h)) * HTB)
#define PG8_SB(b, h) ((4 + (b) * 2 + (h)) * HTB)
#define PG8_STAGE(bufoff, gbase, voff) do { _Pragma("unroll") for (int _i = 0; _i < 2; ++_i) \
        __builtin_amdgcn_global_load_lds((const unsigned*)((const char*)(gbase) + (voff)[_i]), (PG8_LAS unsigned*)(lds + (bufoff) + ldsw + _i * 8192), 16, 0, 0); } while (0)
#define PG8_STGA(bufoff, gbase, H, NX) do { if constexpr (!Gt::ON) { PG8_STAGE(bufoff, (gbase) + (H) * hstep, voffA); } else { \
        const bool nx_ = (NX); unsigned o_[2]; o_[0] = nx_ ? nOA[H][0] : cOA[H][0]; o_[1] = nx_ ? nOA[H][1] : cOA[H][1]; PG8_STAGE(bufoff, gbase, o_); } } while (0)
#define PG8_GOFF(dst, uu) do { _Pragma("unroll") for (int h_ = 0; h_ < 2; ++h_) _Pragma("unroll") for (int i_ = 0; i_ < 2; ++i_) { int R_, C_; stage_rc(tid * 16 + i_ * 8192, R_, C_); dst[h_][i_] = GT.rowoff(uu, h_ * HALF + R_, P) + (unsigned)C_ * 2u; } } while (0)
#define PG8_LDA(dst, b, h) do { if constexpr (F8) { _Pragma("unroll") for (int m = 0; m < 4; ++m) dst##8[m] = cat16(*(const PG8_LAS bf16x8*)(lds + PG8_SA(b, h) + aoff + m * 2048), *(const PG8_LAS bf16x8*)(lds + PG8_SA(b, h) + aoff + m * 2048 + 1024)); } else { \
        _Pragma("unroll") for (int m = 0; m < 4; ++m) _Pragma("unroll") for (int k = 0; k < 2; ++k) dst[m][k] = *(const PG8_LAS bf16x8*)(lds + PG8_SA(b, h) + aoff + m * 2048 + k * KSTR); } } while (0)
#define PG8_LDB(dst, b, h) do { if constexpr (F8) { _Pragma("unroll") for (int n = 0; n < 2; ++n) dst##8[n] = cat16(*(const PG8_LAS bf16x8*)(lds + PG8_SB(b, h) + boff + n * 2048), *(const PG8_LAS bf16x8*)(lds + PG8_SB(b, h) + boff + n * 2048 + 1024)); } else { \
        _Pragma("unroll") for (int n = 0; n < 2; ++n) _Pragma("unroll") for (int k = 0; k < 2; ++k) dst[n][k] = *(const PG8_LAS bf16x8*)(lds + PG8_SB(b, h) + boff + n * 2048 + k * KSTR); } } while (0)
#define PG8_MMA(ai, bj, At, Bt) do { __builtin_amdgcn_s_setprio(1); if constexpr (F8) { _Pragma("unroll") for (int m = 0; m < 4; ++m) _Pragma("unroll") for (int n = 0; n < 2; ++n) \
        asm volatile("v_mfma_scale_f32_16x16x128_f8f6f4 %0, %1, %2, %0, %3, %4 op_sel_hi:[0,0,0]" : "+v"(acc[ai][bj][m][n]) : "v"(Bt##8[n]), "v"(At##8[m]), "v"(sclW), "v"(sclX)); } else { \
        _Pragma("unroll") for (int m = 0; m < 4; ++m) _Pragma("unroll") for (int n = 0; n < 2; ++n) _Pragma("unroll") for (int k = 0; k < 2; ++k) \
        acc[ai][bj][m][n] = __builtin_amdgcn_mfma_f32_16x16x32_bf16(Bt[n][k], At[m][k], acc[ai][bj][m][n], 0, 0, 0); } __builtin_amdgcn_s_setprio(0); } while (0)
#define PG8_WAIT_V(n) asm volatile("s_waitcnt vmcnt(" #n ")" ::: "memory")
#define PG8_WAIT_L(n) asm volatile("s_waitcnt lgkmcnt(" #n ")" ::: "memory")
#define PG8_BAR __builtin_amdgcn_s_barrier()
#define PG8_SCHED __builtin_amdgcn_sched_barrier(0)
    Unit cur, nxt; int ui = 0;
    if (!S.next(0, cur)) return;
    f32x4 acc[2][2][4][2];
#pragma unroll
    for (int a = 0; a < 2; ++a)
#pragma unroll
        for (int b = 0; b < 2; ++b)
#pragma unroll
            for (int m = 0; m < 4; ++m)
#pragma unroll
                for (int n = 0; n < 2; ++n) acc[a][b][m][n] = (f32x4){0.f, 0.f, 0.f, 0.f};
    int sclW = 123, sclX = 127; asm volatile("" : "+v"(sclW), "+v"(sclX));
    bf16x8 At[4][2], B0[2][2], B1[2][2]; v8i32 At8[4], B08[2], B18[2];
    const char* cA = (const char*)g.A + (Gt::ON ? (size_t)0 : (size_t)cur.pm * tstep); unsigned cOA[2][2] = {{0u, 0u}, {0u, 0u}}, nOA[2][2] = {{0u, 0u}, {0u, 0u}}; if constexpr (Gt::ON) { PG8_GOFF(cOA, cur); } const char* cB = (const char*)g.Bt + (size_t)cur.e * g.bstride + (size_t)cur.pn * tstep;
    S.a_ready(cur);
    if constexpr (SP2) {
        PG8_STAGE(PG8_SB(0, 0), cB, voffB); PG8_STAGE(PG8_SB(0, 1), cB + bstep, voffB); PG8_STGA(PG8_SA(0, 0), cA, 0, false); PG8_STGA(PG8_SA(0, 1), cA, 1, false);
        if (wr == 1) PG8_BAR;
        PG8_WAIT_V(2); PG8_BAR;
        PG8_STAGE(PG8_SB(1, 0), cB + kstep, voffB); PG8_STGA(PG8_SA(1, 0), cA + kstep, 0, false); PG8_STAGE(PG8_SB(1, 1), cB + bstep + kstep, voffB);
        PG8_WAIT_V(6); PG8_BAR;
    } else {
        PG8_STAGE(PG8_SB(0, 0), cB, voffB); PG8_STGA(PG8_SA(0, 0), cA, 0, false); PG8_STAGE(PG8_SB(0, 1), cB + bstep, voffB); PG8_STGA(PG8_SA(0, 1), cA, 1, false);
        if (wr == 1) PG8_BAR;
        PG8_WAIT_V(4); PG8_BAR;
        PG8_STAGE(PG8_SB(1, 0), cB + kstep, voffB); PG8_STGA(PG8_SA(1, 0), cA + kstep, 0, false); PG8_STAGE(PG8_SB(1, 1), cB + bstep + kstep, voffB);
        PG8_WAIT_V(6); PG8_BAR;
    }
    for (;;) {
        float pre[2][4]; if constexpr (Epi::HAS_PRE) E.prefetch(cur, wr, fr, pre);
        const bool has_next = S.next(ui + 1, nxt);
        const char* nA = (has_next && !Gt::ON) ? (const char*)g.A + (size_t)nxt.pm * tstep : cA; if constexpr (Gt::ON) { if (has_next) { PG8_GOFF(nOA, nxt); } else { _Pragma("unroll") for (int h_ = 0; h_ < 2; ++h_) _Pragma("unroll") for (int i_ = 0; i_ < 2; ++i_) nOA[h_][i_] = cOA[h_][i_]; } } const char* nB = has_next ? (const char*)g.Bt + (size_t)nxt.e * g.bstride + (size_t)nxt.pn * tstep : cB;
#pragma nounroll
        for (int t = 0; t < nt; t += 2) {
            const bool last = (t == nt - 2);
            const char* a1 = cA + (size_t)(t + 1) * kstep;
            const char* a2 = last ? nA : cA + (size_t)(t + 2) * kstep; const char* b2 = last ? nB : cB + (size_t)(t + 2) * kstep;
            const char* a3 = a2 + kstep; const char* b3 = b2 + kstep;
            if (last && has_next) S.a_ready(nxt);
            if constexpr (SP2) {
            PG8_LDB(B0, 0, 0); PG8_LDB(B1, 0, 1); PG8_SCHED; PG8_LDA(At, 0, 0); PG8_STGA(PG8_SA(1, 1), a1, 1, false);
            PG8_WAIT_V(8); PG8_WAIT_L(0); PG8_BAR; PG8_MMA(0, 0, At, B0); PG8_MMA(0, 1, At, B1); PG8_BAR; PG8_SCHED;
            PG8_LDA(At, 0, 1); PG8_STAGE(PG8_SB(0, 0), b2, voffB); PG8_STAGE(PG8_SB(0, 1), b2 + bstep, voffB); PG8_STGA(PG8_SA(0, 0), a2, 0, last);
            PG8_WAIT_V(8); PG8_WAIT_L(0); PG8_BAR; PG8_MMA(1, 0, At, B0); PG8_MMA(1, 1, At, B1); PG8_BAR; PG8_SCHED;
            PG8_LDB(B0, 1, 0); PG8_LDB(B1, 1, 1); PG8_SCHED; PG8_LDA(At, 1, 0); PG8_STGA(PG8_SA(0, 1), a2, 1, last);
            PG8_WAIT_V(8); PG8_WAIT_L(0); PG8_BAR; PG8_MMA(0, 0, At, B0); PG8_MMA(0, 1, At, B1); PG8_BAR; PG8_SCHED;
            PG8_LDA(At, 1, 1); PG8_STAGE(PG8_SB(1, 0), b3, voffB); PG8_STAGE(PG8_SB(1, 1), b3 + bstep, voffB); PG8_STGA(PG8_SA(1, 0), a3, 0, last);
            PG8_WAIT_V(8); PG8_WAIT_L(0); PG8_BAR; PG8_MMA(1, 0, At, B0); PG8_MMA(1, 1, At, B1); PG8_BAR; PG8_SCHED;
            } else {
            PG8_LDB(B0, 0, 0); PG8_SCHED; PG8_LDA(At, 0, 0); PG8_STGA(PG8_SA(1, 1), a1, 1, false);
            PG8_WAIT_L(8); PG8_BAR; PG8_WAIT_L(0); PG8_MMA(0, 0, At, B0); PG8_BAR; PG8_SCHED;
            PG8_LDB(B1, 0, 1); PG8_STAGE(PG8_SB(0, 0), b2, voffB);
            PG8_BAR; PG8_WAIT_L(0); PG8_MMA(0, 1, At, B1); PG8_BAR;
            PG8_LDA(At, 0, 1); PG8_STGA(PG8_SA(0, 0), a2, 0, last);
            PG8_BAR; PG8_WAIT_L(0); PG8_MMA(1, 0, At, B0); PG8_BAR; PG8_SCHED;
            PG8_STAGE(PG8_SB(0, 1), b2 + bstep, voffB);
            PG8_WAIT_V(6); PG8_BAR; PG8_MMA(1, 1, At, B1); PG8_BAR;
            PG8_LDB(B0, 1, 0); PG8_SCHED; PG8_LDA(At, 1, 0); PG8_STGA(PG8_SA(0, 1), a2, 1, last);
            PG8_WAIT_L(8); PG8_BAR; PG8_WAIT_L(0); PG8_MMA(0, 0, At, B0); PG8_BAR; PG8_SCHED;
            PG8_LDB(B1, 1, 1); PG8_STAGE(PG8_SB(1, 0), b3, voffB);
            PG8_BAR; PG8_WAIT_L(0); PG8_MMA(0, 1, At, B1); PG8_BAR;
            PG8_LDA(At, 1, 1); PG8_STGA(PG8_SA(1, 0), a3, 0, last);
            PG8_BAR; PG8_WAIT_L(0); PG8_MMA(1, 0, At, B0); PG8_BAR; PG8_SCHED;
            PG8_STAGE(PG8_SB(1, 1), b3 + bstep, voffB);
            PG8_WAIT_V(6); PG8_BAR; PG8_MMA(1, 1, At, B1); PG8_BAR;
            }
        }
        if constexpr (F8) asm volatile("s_nop 15\n\ts_nop 15" : "+v"(acc[1][1][0][0]), "+v"(acc[1][1][0][1]), "+v"(acc[1][1][1][0]), "+v"(acc[1][1][1][1]), "+v"(acc[1][1][2][0]), "+v"(acc[1][1][2][1]), "+v"(acc[1][1][3][0]), "+v"(acc[1][1][3][1]));
        if constexpr (ALIGN_EPI) { if (wr == 0) PG8_BAR; }
        if constexpr (!Epi::AFTER_DRAIN) { if constexpr (Epi::HAS_PRE) E(acc, cur, wr, wc, fr, fq, pre); else E(acc, cur, wr, wc, fr, fq); S.done(cur); }
        if (!has_next) break;
#pragma unroll
        for (int a = 0; a < 2; ++a)
#pragma unroll
            for (int b = 0; b < 2; ++b)
#pragma unroll
                for (int m = 0; m < 4; ++m)
#pragma unroll
                    for (int n = 0; n < 2; ++n) acc[a][b][m][n] = (f32x4){0.f, 0.f, 0.f, 0.f};
        cur = nxt; cA = nA; cB = nB; ++ui; if constexpr (Gt::ON) { _Pragma("unroll") for (int h_ = 0; h_ < 2; ++h_) _Pragma("unroll") for (int i_ = 0; i_ < 2; ++i_) cOA[h_][i_] = nOA[h_][i_]; }
        if constexpr (ALIGN_EPI) { if (wr == 1) PG8_BAR; }
    }
    PG8_WAIT_V(0);
    if constexpr (!ALIGN_EPI) { if (wr == 0) PG8_BAR; }
    PG8_BAR;
    if constexpr (Epi::AFTER_DRAIN) { E.fused(acc, cur, wr, wc, fr, fq, lds, wid, lane); S.done(cur); }
#undef PG8_SA
#undef PG8_SB
#undef PG8_STAGE
#undef PG8_LDA
#undef PG8_STGA
#undef PG8_GOFF
#undef PG8_LDB
#undef PG8_MMA
#undef PG8_WAIT_V
#undef PG8_WAIT_L
#undef PG8_BAR
#undef PG8_SCHED
}
}


#define PG8_SP2 true
#define PG8_ALIGN true

#include <hip/hip_bf16.h>
#include <cmath>
namespace attn_body {
using bf16=__hip_bfloat16;
using bf16x8=__attribute__((ext_vector_type(8)))short;
using s16x4=__attribute__((ext_vector_type(4)))short;
using f32x16=__attribute__((ext_vector_type(16)))float;
using u32x4=__attribute__((ext_vector_type(4)))unsigned;
constexpr int BATCH=8,NHC=8,SEQ=4096,D=64,DV=128,PQ=512,PO=1024;
constexpr int NW=8,QBLK=32,QB=QBLK*NW,KVBLK=64,NQB=SEQ/QB;
constexpr int ATTN_UNIT_ROWS=QB;
__device__ __forceinline__ int crow(int r,int hi){return (r&3)+8*(r>>2)+4*hi;}
#define SBAR() __builtin_amdgcn_sched_barrier(0)
__device__ __forceinline__ void cmask(f32x16&p0,f32x16&p1,int jb,int qrel,int hi,const __attribute__((address_space(3))) float*dl){
  const __attribute__((address_space(3))) float*e=dl+(256+qrel-64*(jb-2)-4*hi);
  #pragma unroll
  for(int r=0;r<16;++r){const int o=(r&3)+8*(r>>2); p0[r]=__builtin_fminf(p0[r],16384.f)+e[-o]; p1[r]=__builtin_fminf(p1[r],16384.f)+e[-o-32];}
}
constexpr int NSLOT=3, SLOTB=8192;
constexpr int LDS_K=0, LDS_V=NSLOT*SLOTB, LDS_WS=LDS_V+NSLOT*2*SLOTB, LDS_OST=LDS_WS+NW*64*4, LDS_QS=LDS_OST+NW*4096, LDS_BYTES=LDS_QS+NW*4096;
constexpr float C2=0.125f*1.4426950408889634f;
__device__ __forceinline__ void glds16(const void*gsrc,unsigned lds_dst){unsigned keep;
  asm volatile("s_mov_b32 %0, m0\n\ts_mov_b32 m0, %2\n\ts_nop 0\n\tglobal_load_lds_dwordx4 %1, off\n\ts_mov_b32 m0, %0":"=&s"(keep):"v"(gsrc),"s"(lds_dst):"memory");}
__device__ __forceinline__ float max3f(float a,float b,float c){float r;asm("v_max3_f32 %0, %1, %2, %3":"=v"(r):"v"(a),"v"(b),"v"(c));return r;}
__device__ __forceinline__ float max2f(float a,float b){float r;asm("v_max_f32_e32 %0, %1, %2":"=v"(r):"v"(a),"v"(b));return r;}
__device__ __forceinline__ float fadd_s(float a,float b){float r;asm("v_add_f32_e32 %0, %1, %2":"=v"(r):"v"(a),"v"(b));return r;}
__device__ __forceinline__ float fsub_s(float a,float b){float r;asm("v_sub_f32_e32 %0, %1, %2":"=v"(r):"v"(a),"v"(b));return r;}
typedef float f32x2_t __attribute__((ext_vector_type(2))); typedef __bf16 bf16x2_t __attribute__((ext_vector_type(2)));
__device__ __forceinline__ unsigned cvtpk_s(float lo,float hi){f32x2_t v={lo,hi};bf16x2_t b=__builtin_convertvector(v,bf16x2_t);return __builtin_bit_cast(unsigned,b);}
#define WAIT_BAR(N) asm volatile("s_waitcnt vmcnt(" #N ") lgkmcnt(0)\n\ts_barrier":::"memory")

__device__ __forceinline__ void qkt(f32x16&p0,f32x16&p1,const char*Kslot,const bf16x8*qr,const f32x16&negm,int r32,int hi){
  const char*kb=Kslot+hi*1024+r32*16;
  #pragma unroll
  for(int d0=0;d0<4;++d0){
    const bf16x8 b0=*reinterpret_cast<const bf16x8*>(kb+d0*2048);
    const bf16x8 b1=*reinterpret_cast<const bf16x8*>(kb+d0*2048+512);
    if(d0==0){p0=__builtin_amdgcn_mfma_f32_32x32x16_bf16(b0,qr[0],negm,0,0,0);p1=__builtin_amdgcn_mfma_f32_32x32x16_bf16(b1,qr[0],negm,0,0,0);}
    else{p0=__builtin_amdgcn_mfma_f32_32x32x16_bf16(b0,qr[d0],p0,0,0,0);p1=__builtin_amdgcn_mfma_f32_32x32x16_bf16(b1,qr[d0],p1,0,0,0);}}
}
typedef __attribute__((address_space(3))) const char* lds_cptr;
typedef short v4i16_t __attribute__((ext_vector_type(4)));
__device__ __forceinline__ void kload8(bf16x8*kf,lds_cptr kp){
  kf[0]=*(const __attribute__((address_space(3))) bf16x8*)(kp);      kf[1]=*(const __attribute__((address_space(3))) bf16x8*)(kp+512);
  kf[2]=*(const __attribute__((address_space(3))) bf16x8*)(kp+2048); kf[3]=*(const __attribute__((address_space(3))) bf16x8*)(kp+2560);
  kf[4]=*(const __attribute__((address_space(3))) bf16x8*)(kp+4096); kf[5]=*(const __attribute__((address_space(3))) bf16x8*)(kp+4608);
  kf[6]=*(const __attribute__((address_space(3))) bf16x8*)(kp+6144); kf[7]=*(const __attribute__((address_space(3))) bf16x8*)(kp+6656);
}
__device__ __forceinline__ void kload2(bf16x8*kf,lds_cptr kp,int j){ kf[2*j]=*(const __attribute__((address_space(3))) bf16x8*)(kp+j*2048); kf[2*j+1]=*(const __attribute__((address_space(3))) bf16x8*)(kp+j*2048+512); }
__device__ __forceinline__ s16x4 vtr(lds_cptr p){ return __builtin_bit_cast(s16x4,__builtin_amdgcn_ds_read_tr16_b64_v4i16((__attribute__((address_space(3))) v4i16_t*)p)); }
__device__ __forceinline__ float rowmax(const f32x16&p0,const f32x16&p1){
  float a=max3f(p0[0],p0[1],p1[0]),b=max3f(p0[2],p0[3],p1[1]);a=max3f(a,p1[2],p1[3]);
  #pragma unroll
  for(int r=4;r<16;r+=4){a=max3f(a,p0[r],p0[r+1]);b=max3f(b,p0[r+2],p0[r+3]);a=max3f(a,p1[r],p1[r+1]);b=max3f(b,p1[r+2],p1[r+3]);}
  const float m=max2f(a,b);
  auto rr=__builtin_amdgcn_permlane32_swap(__float_as_uint(m),__float_as_uint(m),false,false);
  return max2f(__uint_as_float(rr[0]),__uint_as_float(rr[1]));
}
__device__ __forceinline__ void pv(f32x16*o,int vb,bf16x8 pa0,bf16x8 pa1,bf16x8 pa2,bf16x8 pa3){
  #pragma unroll
  for(int d0=0;d0<4;++d0){s16x4 lo[4],hi[4];
    #pragma unroll
    for(int ks=0;ks<4;++ks){
      asm volatile("ds_read_b64_tr_b16 %0,%1 offset:%c2":"=&v"(lo[ks]):"v"(vb),"i"(d0*4096+ks*1024):"memory");
      asm volatile("ds_read_b64_tr_b16 %0,%1 offset:%c2":"=&v"(hi[ks]):"v"(vb),"i"(d0*4096+ks*1024+512):"memory");}
    asm volatile("s_waitcnt lgkmcnt(0)":::"memory");SBAR();
    #define PK(k) (bf16x8){lo[k][0],lo[k][1],lo[k][2],lo[k][3],hi[k][0],hi[k][1],hi[k][2],hi[k][3]}
    o[d0]=__builtin_amdgcn_mfma_f32_32x32x16_bf16(pa0,PK(0),o[d0],0,0,0);
    o[d0]=__builtin_amdgcn_mfma_f32_32x32x16_bf16(pa1,PK(1),o[d0],0,0,0);
    o[d0]=__builtin_amdgcn_mfma_f32_32x32x16_bf16(pa2,PK(2),o[d0],0,0,0);
    o[d0]=__builtin_amdgcn_mfma_f32_32x32x16_bf16(pa3,PK(3),o[d0],0,0,0);
    #undef PK
  }
}

#ifndef ATTN_STORE16
#define ATTN_STORE16(p,v) (*(u32x4*)(p)=(v))
#endif
template<int THRL> __device__ __forceinline__ void attn_unit(int b,int hc,int qb,const bf16*Q,const bf16*__restrict__ K,const bf16*__restrict__ V,bf16*O,char*shm,const __attribute__((address_space(3))) float*dltab){
  asm volatile("":"+s"(b),"+s"(hc),"+s"(qb));
  int zl_=0; asm volatile("":"+v"(zl_));
  const int tid=(int)threadIdx.x+zl_,lane=tid&63,r32=lane&31,hi=lane>>5; const int wid=__builtin_amdgcn_readfirstlane(tid>>6);
  const long rowbase=(long)b*SEQ; const int q0=qb*QB;
  const int qcol=hc*D, vcol=(hc>>1)*DV, ocol=(hc&1)*512+(hc>>1)*DV;
  const __attribute__((address_space(3))) float*dl=dltab+(hc>>1)*640;
  const bf16*Qw=Q+(rowbase+q0+wid*QBLK)*PQ+qcol;
  const bf16*Kh=K+rowbase*PQ+qcol,*Vh=V+rowbase*PQ+vcol;
  const unsigned lds0=(unsigned)(uintptr_t)shm;
  float*wsf=(float*)(shm+LDS_WS)+wid*64;
  const bf16*ksrc=Kh+(long)lane*PQ+wid*8;
  const bf16*vsrc=Vh+(long)(16*(wid&3)+(lane>>2))*PQ+(wid>>2)*32+(lane&3)*8;
  const unsigned kdst=lds0+LDS_K+wid*1024, vdst=lds0+LDS_V+wid*1024;
  #define DMA_K(t,slot) glds16(ksrc+(long)(t)*KVBLK*PQ,(unsigned)__builtin_amdgcn_readfirstlane(kdst+(slot)))
  #define DMA_V(t,slot) do{ glds16(vsrc+(long)(t)*KVBLK*PQ,(unsigned)__builtin_amdgcn_readfirstlane(vdst+2*(slot))); glds16(vsrc+64+(long)(t)*KVBLK*PQ,(unsigned)__builtin_amdgcn_readfirstlane(vdst+2*(slot)+8192)); }while(0)
  const int vb0=(int)(lds0+LDS_V)+((lane>>4)&1)*32+(lane&3)*8+(4*hi+((lane&15)>>2))*64;
  const char*Kbase=shm+LDS_K; bf16x8 kf[8];
  const lds_cptr shm3=(lds_cptr)shm; const lds_cptr kp0=shm3+LDS_K+hi*1024+r32*16; const lds_cptr vp0=shm3+LDS_V+((lane>>4)&1)*32+(lane&3)*8+(4*hi+((lane&15)>>2))*64;
  const int NT=(q0+QB)/KVBLK;
  DMA_K(0,0);DMA_V(0,0);DMA_K(1,SLOTB);
  bf16x8 qr[4];
  #pragma unroll
  for(int d0=0;d0<4;++d0)qr[d0]=*reinterpret_cast<const bf16x8*>(&Qw[(long)r32*PQ+d0*16+hi*8]);
  const lds_cptr qp=(lds_cptr)shm+LDS_QS+wid*4096+lane*16;
  float mhat=0.f,l_reg=0.f;f32x16 o[4];f32x16 negm;
  const int qrel=wid*QBLK+r32;
  #define CMASK(P0,P1,t) do{int jb_=(t)-(NT-6); if(jb_>=0)cmask(P0,P1,jb_,qrel,hi,dl);}while(0)
  bool resc=false;
  #define START(P0,P1) do{ const float rm=rowmax(P0,P1); resc=false; \
    { const float dl=rm; mhat=fadd_s(mhat,dl); \
      _Pragma("unroll") for(int r=0;r<16;++r){P0[r]=fsub_s(P0[r],dl);P1[r]=fsub_s(P1[r],dl);} \
      _Pragma("unroll") for(int r=0;r<16;++r)negm[r]=-mhat; asm volatile("":"+v"(negm)); } \
    _Pragma("unroll") for(int r=0;r<16;++r)P0[r]=__builtin_amdgcn_exp2f(P0[r]); }while(0)
  #define RESC() do{ if(resc){ asm volatile("s_waitcnt lgkmcnt(0)":::"memory"); \
      _Pragma("unroll") for(int d_=0;d_<4;++d_) _Pragma("unroll") for(int r=0;r<16;++r)o[d_][r]*=wsf[crow(r,hi)]; } }while(0)
  f32x16 pA0,pA1,pB0,pB1;
  int sl_prev=0,sl_cur=0,sl_next=SLOTB;
  #define ROT() do{sl_prev=sl_cur;sl_cur=sl_next;sl_next=(sl_next==(NSLOT-1)*SLOTB)?0:sl_next+SLOTB;}while(0)
  DMA_K(2,2*SLOTB);
  WAIT_BAR(4);
  { float z_=0.f; asm volatile("":"+v"(z_)); _Pragma("unroll") for(int r=0;r<16;++r)negm[r]=z_; _Pragma("unroll") for(int d_=0;d_<4;++d_) _Pragma("unroll") for(int r=0;r<16;++r)o[d_][r]=z_; } asm volatile("":"+v"(negm));
  qkt(pA0,pA1,Kbase,qr,negm,r32,hi);asm volatile("s_nop 15\n\ts_nop 7":"+v"(pA0),"+v"(pA1));CMASK(pA0,pA1,0);
  START(pA0,pA1);
  _Pragma("unroll") for(int d0=0;d0<4;++d0)*(__attribute__((address_space(3))) bf16x8*)(qp+d0*1024)=qr[d0];
  _Pragma("unroll") for(int r=0;r<16;++r)pA1[r]=__builtin_amdgcn_exp2f(pA1[r]);
  WAIT_BAR(0);
  DMA_K(3,0);DMA_V(1,SLOTB);
  ROT();
  kload8(kf,kp0+sl_cur);
  WAIT_BAR(3);
  s16x4 vlo[8],vhi[8]; u32x4 pw0,pw1,pw2,pw3;
  #define PKW(P,B) cvtpk_s(P[B],P[B+1])
  #define PAF(k) __builtin_bit_cast(bf16x8,pw##k)
  #define VFR(i) (bf16x8){vlo[i][0],vlo[i][1],vlo[i][2],vlo[i][3],vhi[i][0],vhi[i][1],vhi[i][2],vhi[i][3]}
  #define PIN(x) asm volatile("":"+v"(x))
  #define MX3(a,b,c) __builtin_fmaxf(__builtin_fmaxf((a),(b)),(c))
  #define GAPA(MF,A0,A1,A2,A3,W0,W1,PW) do{ MF; sacc+=A0; sacc+=A1; sacc+=A2; sacc+=A3; PIN(sacc); W0; W1; PIN(PW); SBAR(); }while(0)
  #define EX(v) __builtin_amdgcn_exp2f(v)
  #define GAPB1(MF,i,X,B) do{ MF; VRD2(i); X[B]=EX(X[B]); X[B+1]=EX(X[B+1]); PIN(X); SBAR(); }while(0)
  #define GAPB2(MF,X,B) do{ MF; X[B]=EX(X[B]); X[B+1]=EX(X[B+1]); PIN(X); SBAR(); }while(0)
  #define VRD(i) do{ vlo[i]=vtr(vp_+(((i)>>2)*4096+((i)&3)*1024)); vhi[i]=vtr(vp_+(((i)>>2)*4096+((i)&3)*1024+512)); }while(0)
  #define VRD2(i) do{ vlo[i]=vtr(vp_+(8192+((i)>>2)*4096+((i)&3)*1024)); vhi[i]=vtr(vp_+(8192+((i)>>2)*4096+((i)&3)*1024+512)); }while(0)
  #define QLD(d0) ((d0)<2 ? qr[d0] : *(const __attribute__((address_space(3))) bf16x8*)(qp+(d0)*1024))
  #define KRD(G,j) do{ if(G){ kload2(kf,kp0+sl_next,j); SBAR(); } }while(0)
  #define STEP(C0,C1,P0,P1,t,GK,GV,GL) do{ SBAR(); \
    const lds_cptr vp_=vp0+2*sl_prev; \
    bf16x8 qf=QLD(0); VRD(0); SBAR(); float sacc=(P0[0]+P0[1]); \
    GAPA(C0=__builtin_amdgcn_mfma_f32_32x32x16_bf16(kf[0],qf,negm,0,0,0), P0[2],P0[3],P0[4],P0[5],     pw0[0]=PKW(P0,0), pw0[1]=PKW(P0,2), pw0); \
    VRD(4); SBAR(); GAPA(C1=__builtin_amdgcn_mfma_f32_32x32x16_bf16(kf[1],qf,negm,0,0,0), P0[6],P0[7],P0[8],P0[9],     pw0[2]=PKW(P0,4), pw0[3]=PKW(P0,6), pw0); \
    qf=QLD(1); VRD(1); SBAR(); GAPA(C0=__builtin_amdgcn_mfma_f32_32x32x16_bf16(kf[2],qf,C0,0,0,0),   P0[10],P0[11],P0[12],P0[13], pw1[0]=PKW(P0,8), pw1[1]=PKW(P0,10), pw1); \
    VRD(5); SBAR(); GAPA(C1=__builtin_amdgcn_mfma_f32_32x32x16_bf16(kf[3],qf,C1,0,0,0),   P0[14],P0[15],P1[0],P1[1],   pw1[2]=PKW(P0,12),pw1[3]=PKW(P0,14), pw1); \
    qf=QLD(2); VRD(2); SBAR(); GAPA(C0=__builtin_amdgcn_mfma_f32_32x32x16_bf16(kf[4],qf,C0,0,0,0),   P1[2],P1[3],P1[4],P1[5],     pw2[0]=PKW(P1,0), pw2[1]=PKW(P1,2), pw2); \
    VRD(6); SBAR(); GAPA(C1=__builtin_amdgcn_mfma_f32_32x32x16_bf16(kf[5],qf,C1,0,0,0),   P1[6],P1[7],P1[8],P1[9],     pw2[2]=PKW(P1,4), pw2[3]=PKW(P1,6), pw2); \
    qf=QLD(3); VRD(3); SBAR(); GAPA(C0=__builtin_amdgcn_mfma_f32_32x32x16_bf16(kf[6],qf,C0,0,0,0),   P1[10],P1[11],P1[12],P1[13], pw3[0]=PKW(P1,8), pw3[1]=PKW(P1,10), pw3); \
    VRD(7); SBAR(); GAPA(C1=__builtin_amdgcn_mfma_f32_32x32x16_bf16(kf[7],qf,C1,0,0,0),   P1[14],P1[15],0.f,0.f,       pw3[2]=PKW(P1,12),pw3[3]=PKW(P1,14), pw3); \
    l_reg+=sacc; \
    if(GK){DMA_K((t)+3,sl_cur);} if(GV){DMA_V((t)+1,sl_next);} \
    CMASK(C0,C1,t); \
    { float a=MX3(C0[0],C0[1],C1[0]),b=MX3(C0[2],C0[3],C1[1]); a=MX3(a,C1[2],C1[3]); \
      _Pragma("unroll") for(int r=4;r<16;r+=4){a=MX3(a,C0[r],C0[r+1]);b=MX3(b,C0[r+2],C0[r+3]);a=MX3(a,C1[r],C1[r+1]);b=MX3(b,C1[r+2],C1[r+3]);} \
      float rm=__builtin_fmaxf(a,b); { auto rr=__builtin_amdgcn_permlane32_swap(__float_as_uint(rm),__float_as_uint(rm),false,false); rm=__builtin_fmaxf(__uint_as_float(rr[0]),__uint_as_float(rr[1])); } \
      resc=false; \
      if(__builtin_expect(__any(rm>(float)THRL),0)){ const float dl=__builtin_fmaxf(rm,0.f); mhat+=dl; \
        _Pragma("unroll") for(int r=0;r<16;++r){C0[r]-=dl;C1[r]-=dl;} \
        _Pragma("unroll") for(int r=0;r<16;++r)negm[r]=-mhat; asm volatile("":"+v"(negm)); \
        const float f=__builtin_amdgcn_exp2f(-dl); l_reg*=f; if(hi==0)wsf[r32]=f; resc=true; } } \
    SBAR(); \
    GAPB1(o[0]=__builtin_amdgcn_mfma_f32_32x32x16_bf16(PAF(0),VFR(0),o[0],0,0,0), 0, C0,0); \
    GAPB1(o[1]=__builtin_amdgcn_mfma_f32_32x32x16_bf16(PAF(0),VFR(4),o[1],0,0,0), 4, C0,2); \
    GAPB1(o[0]=__builtin_amdgcn_mfma_f32_32x32x16_bf16(PAF(1),VFR(1),o[0],0,0,0), 1, C0,4); \
    GAPB1(o[1]=__builtin_amdgcn_mfma_f32_32x32x16_bf16(PAF(1),VFR(5),o[1],0,0,0), 5, C0,6); \
    GAPB1(o[0]=__builtin_amdgcn_mfma_f32_32x32x16_bf16(PAF(2),VFR(2),o[0],0,0,0), 2, C0,8); \
    GAPB1(o[1]=__builtin_amdgcn_mfma_f32_32x32x16_bf16(PAF(2),VFR(6),o[1],0,0,0), 6, C0,10); \
    GAPB1(o[0]=__builtin_amdgcn_mfma_f32_32x32x16_bf16(PAF(3),VFR(3),o[0],0,0,0), 3, C0,12); \
    GAPB1(o[1]=__builtin_amdgcn_mfma_f32_32x32x16_bf16(PAF(3),VFR(7),o[1],0,0,0), 7, C0,14); \
    GAPB2(o[2]=__builtin_amdgcn_mfma_f32_32x32x16_bf16(PAF(0),VFR(0),o[2],0,0,0), C1,0); \
    GAPB2(o[3]=__builtin_amdgcn_mfma_f32_32x32x16_bf16(PAF(0),VFR(4),o[3],0,0,0), C1,2); \
    KRD(GL,0); GAPB2(o[2]=__builtin_amdgcn_mfma_f32_32x32x16_bf16(PAF(1),VFR(1),o[2],0,0,0), C1,4); \
    KRD(GL,1); GAPB2(o[3]=__builtin_amdgcn_mfma_f32_32x32x16_bf16(PAF(1),VFR(5),o[3],0,0,0), C1,6); \
    KRD(GL,2); GAPB2(o[2]=__builtin_amdgcn_mfma_f32_32x32x16_bf16(PAF(2),VFR(2),o[2],0,0,0), C1,8); \
    KRD(GL,3); GAPB2(o[3]=__builtin_amdgcn_mfma_f32_32x32x16_bf16(PAF(2),VFR(6),o[3],0,0,0), C1,10); \
    GAPB2(o[2]=__builtin_amdgcn_mfma_f32_32x32x16_bf16(PAF(3),VFR(3),o[2],0,0,0), C1,12); \
    GAPB2(o[3]=__builtin_amdgcn_mfma_f32_32x32x16_bf16(PAF(3),VFR(7),o[3],0,0,0), C1,14); \
    }while(0)
  int t=1;
  if(wid>=4)__builtin_amdgcn_s_setprio(1);
  #undef CMASK
  #define CMASK(P0,P1,t) do{}while(0)
  for(;t+7<NT;t+=2){
    STEP(pB0,pB1,pA0,pA1,t,true,true,true);     WAIT_BAR(3); RESC(); ROT();
    STEP(pA0,pA1,pB0,pB1,t+1,true,true,true);   WAIT_BAR(3); RESC(); ROT();
  }
  #undef CMASK
  #define CMASK(P0,P1,t) do{int jb_=(t)-(NT-6); if(jb_>=0)cmask(P0,P1,jb_,qrel,hi,dl);}while(0)
  #define ENDW(tt) do{ if((tt)+3<NT){WAIT_BAR(3);} else if((tt)+2<NT){WAIT_BAR(2);} else {WAIT_BAR(0);} }while(0)
  for(;t+1<NT;t+=2){
    STEP(pB0,pB1,pA0,pA1,t,(t+3<NT),(t+1<NT),(t+1<NT));       ENDW(t);   RESC(); ROT();
    STEP(pA0,pA1,pB0,pB1,t+1,(t+4<NT),(t+2<NT),(t+2<NT));     ENDW(t+1); RESC(); ROT();
  }
  STEP(pB0,pB1,pA0,pA1,NT-1,false,false,false); RESC(); __builtin_amdgcn_s_setprio(0);
  { float sacc=pB0[0]+pB0[1]; _Pragma("unroll") for(int r=2;r<16;++r)sacc+=pB0[r]; _Pragma("unroll") for(int r=0;r<16;++r)sacc+=pB1[r]; l_reg+=sacc;
    pw0=(u32x4){PKW(pB0,0),PKW(pB0,2),PKW(pB0,4),PKW(pB0,6)};pw1=(u32x4){PKW(pB0,8),PKW(pB0,10),PKW(pB0,12),PKW(pB0,14)};pw2=(u32x4){PKW(pB1,0),PKW(pB1,2),PKW(pB1,4),PKW(pB1,6)};pw3=(u32x4){PKW(pB1,8),PKW(pB1,10),PKW(pB1,12),PKW(pB1,14)};
    SBAR(); pv(o,vb0+2*sl_cur,PAF(0),PAF(1),PAF(2),PAF(3)); }
  #undef PKW
  #undef PAF
  #undef VFR
  #undef PIN
  #undef MX3
  #undef GAPA
  #undef GAPB1
  #undef GAPB2
  #undef VRD2
  #undef EX
  #undef VRD
  #undef KRD
  #undef QLD
  #undef STEP
  #undef ENDW
  {auto rr=__builtin_amdgcn_permlane32_swap(__float_as_uint(l_reg),__float_as_uint(l_reg),false,false);l_reg=__uint_as_float(rr[0])+__uint_as_float(rr[1]);}
  if(hi==0)wsf[32+r32]=l_reg;asm volatile("s_waitcnt lgkmcnt(0)":::"memory");
  float rli[16];
  #pragma unroll
  for(int r=0;r<16;++r)rli[r]=__builtin_amdgcn_rcpf(wsf[32+crow(r,hi)]);
  bf16*Ow=O+(rowbase+q0+wid*QBLK)*PO+ocol;
  { bf16*stg=(bf16*)(shm+LDS_OST)+wid*2048;
    #pragma unroll
    for(int hp=0;hp<2;++hp){
      #pragma unroll
      for(int r=0;r<16;++r){const int orow=crow(r,hi);
        #pragma unroll
        for(int d0=0;d0<2;++d0)stg[orow*64+d0*32+r32]=__float2bfloat16(o[2*hp+d0][r]*rli[r]);}
      asm volatile("s_waitcnt lgkmcnt(0)":::"memory");
      #pragma unroll
      for(int i=0;i<4;++i){const int row=i*8+(lane>>3),ch=lane&7; const u32x4 v=*(const u32x4*)(stg+row*64+ch*8); ATTN_STORE16(Ow+(long)row*PO+hp*64+ch*8,v);}
      asm volatile("s_waitcnt lgkmcnt(0)":::"memory");
    } }
  asm volatile("s_waitcnt lgkmcnt(0)\n\ts_barrier":::"memory");
  #undef DMA_K
  #undef DMA_V
  #undef CMASK
  #undef START
  #undef RESC
  #undef ROT
}
constexpr int ATTN_LDS_BYTES=LDS_BYTES;
struct AttnTensors { const bf16* Q; const bf16* K; const bf16* V; bf16* O; };
struct AttnUnit { int b; int hc; int qb; };
struct StaticOrder {
  int vcu;
  __device__ __forceinline__ explicit StaticOrder(int grid,int block):vcu((block%8)*(grid/8)+block/8){}
  __device__ __forceinline__ bool next(int i,AttnUnit&u)const{ if(i>=4||vcu>=256)return false; const int p=vcu&7,bh=vcu>>3; u.b=bh>>2; u.hc=(bh&3)*2+(i>>1); u.qb=(i&1)?p:15-p; return true; }
  __device__ __forceinline__ void a_ready(const AttnUnit&)const{}
  __device__ __forceinline__ void done(const AttnUnit&)const{}
};
template<class Sched,int THRL=8> __device__ __forceinline__ void attn_phase(char*lds,const AttnTensors&T,const Sched&S,const __attribute__((address_space(3))) float*dltab){
  AttnUnit u;
  for(int i=0;S.next(i,u);++i){ S.a_ready(u); attn_unit<THRL>(u.b,u.hc,u.qb,T.Q,T.K,T.V,T.O,lds,dltab); S.done(u); }
}
#undef SBAR
#undef WAIT_BAR
}

constexpr int NWAVES = 8;
#ifndef MK_PER_PHASE
#define MK_PER_PHASE 0
#endif
constexpr int BATCH = 8, SEQ = 4096, D = 1024, M = BATCH * SEQ;
constexpr int NPROJ = 3072, DH = 512, NH = 4, HD = 128, CHUNK = 128, NCH = SEQ / CHUNK, NU3 = BATCH * NH * NCH;
constexpr int NEXP = 32, FFE = 512, MAXT = 288;
constexpr float EPS_RMS = 1e-6f, EPS_SUB = 1e-5f, LAM_INIT = 0.2f, KSCALE = 0.08838834764831845f  ;
constexpr float LOG2E = 1.4426950408889634f;

constexpr size_t MiB = 1u << 20, KiB = 1024;
constexpr size_t WS_CTL = 0, CTL_ZERO_BYTES = 20480;
constexpr size_t WS_WIN = 2 * MiB, WS_WOUT = 8 * MiB, WS_WQ = 10 * MiB, WS_WK = 10 * MiB + 128 * KiB, WS_WG = 10 * MiB + 256 * KiB, WS_WR = 10 * MiB + 320 * KiB, WS_WC = 10 * MiB + 448 * KiB;
constexpr size_t WS_WGU = 12 * MiB, WS_WD = 76 * MiB;
constexpr size_t WS_HB = 108 * MiB;
constexpr size_t OUT_A2 = 64 * MiB;
constexpr size_t WS_PC = 172 * MiB, WS_PV = 204 * MiB, WS_PZ = 236 * MiB, WS_PQ = 268 * MiB, WS_PK = 300 * MiB, WS_PVD = 332 * MiB;
constexpr size_t WS_CP = WS_PC;
constexpr size_t WS_MQ = 364 * MiB, WS_MK = 396 * MiB, WS_CA = 428 * MiB;
constexpr size_t WS_WIN8 = 6 * MiB;
constexpr size_t WS_H8 = 428 * MiB;
constexpr size_t WS_X1B = 396 * MiB;
constexpr size_t WS_XP = 172 * MiB;
constexpr size_t WS_Y = WS_XP;
constexpr size_t WS_HID = 316 * MiB;
constexpr size_t WS_X1F8 = 352 * MiB;
constexpr size_t WS_SM = 460 * MiB;
constexpr size_t SM_GI = WS_SM, SM_GF = WS_SM + 512 * KiB, SM_GB = WS_SM + 1024 * KiB, SM_GMAX = WS_SM + 1536 * KiB, SM_BEND = WS_SM + 1540 * KiB, SM_MPREV = WS_SM + 1544 * KiB;
constexpr size_t SM_DN = WS_SM + 1552 * KiB, SM_NP = WS_SM + 2064 * KiB, SM_EID = WS_SM + 2576 * KiB, SM_GATE = WS_SM + 2832 * KiB, SM_POS = WS_SM + 3088 * KiB, SM_ROWTOK = WS_SM + 3344 * KiB, SM_RMS1 = SM_ROWTOK;
constexpr size_t WS_RT = 464 * MiB; constexpr int RT_CAP = 65536;
constexpr size_t WS_RS = 472 * MiB;
constexpr size_t WS_END = 480 * MiB;
static_assert(WS_HID + (size_t)MAXT * 256 * FFE * 2 <= WS_SM && WS_XP + (size_t)MAXT * 256 * D * 2 <= WS_HID && SM_ROWTOK + (size_t)MAXT * 256 * 4 <= WS_RT, "d_ws map");
constexpr int CW_TMO = 0, CW_CODE = 1, CW_BAR = 1024, CW_CUR = 4608;
static_assert((CW_CUR + 64) * 4 <= (int)CTL_ZERO_BYTES && CW_BAR + 3456 <= CW_CUR, "CTL words inside the memset region");

constexpr int RING_OFF = 0, RING_BYTES = 131072;
constexpr int LDS_BYTES = 163840;
constexpr int LDSCTL_OFF = LDS_BYTES - 512, MISC_OFF = LDSCTL_OFF + 320;
constexpr int EXB = 147456;
constexpr int EX_DL = EXB;
constexpr int EX_TE = EXB + 4 * 132 * 4;
constexpr int EX_OFF = EX_TE + 320 * 4;
constexpr int EX_CNT = EX_OFF + 40 * 4;
constexpr int EX_HIST = EX_CNT + 40 * 4;
constexpr int EX_ROW = EX_HIST + 64 * 4;
constexpr int EX_SM = EXB + 5120;
static_assert(EX_SM + 8192 <= LDSCTL_OFF, "LDS map");
static_assert(attn_body::ATTN_LDS_BYTES <= EXB, "attention scratch vs LDS map");
static_assert(EX_ROW + 1024 <= EX_SM, "LDS map");

#define GAS __attribute__((address_space(1)))
#define LAS __attribute__((address_space(3)))
typedef unsigned short bf16;
typedef unsigned v4u __attribute__((ext_vector_type(4)));
typedef unsigned v2u __attribute__((ext_vector_type(2)));
typedef float f32x4 __attribute__((ext_vector_type(4)));
typedef short bf16x8 __attribute__((ext_vector_type(8)));
typedef GAS unsigned gu32;
typedef GAS unsigned long long gu64;
#define RLX_AGENT __ATOMIC_RELAXED, __HIP_MEMORY_SCOPE_AGENT
#define LDS_WAIT() asm volatile("s_waitcnt lgkmcnt(0)" ::: "memory")
#define VM_WAIT() asm volatile("s_waitcnt vmcnt(0)" ::: "memory")
__device__ __forceinline__ unsigned f2bf(float f) { unsigned u = __builtin_bit_cast(unsigned, f); return (u + 0x7fffu + ((u >> 16) & 1u)) >> 16; }
__device__ __forceinline__ unsigned pk2(float lo, float hi) { return f2bf(lo) | (f2bf(hi) << 16); }
__device__ __forceinline__ float bflo(unsigned w) { return __builtin_bit_cast(float, w << 16); }
__device__ __forceinline__ float bfhi(unsigned w) { return __builtin_bit_cast(float, w & 0xffff0000u); }
__device__ __forceinline__ float bf1(unsigned short h) { return __builtin_bit_cast(float, (unsigned)h << 16); }
__device__ __forceinline__ float fast_exp(float x) { return __builtin_amdgcn_exp2f(x * LOG2E); }
__device__ __forceinline__ float sigmoidf_(float x) { return __builtin_amdgcn_rcpf(1.0f + __builtin_amdgcn_exp2f(-LOG2E * x)); }

#define XB_TMO      128
#define XB_XCNT(j)  (256  + 64 * (j))
#define XB_XSUB(j)  (1280 + 64 * (j))
#define XB_XGEN(j)  (2304 + 64 * (j))
#define XB_TOP      3328
#define XB_TOPGEN   3392
#define XCD_BAR_WORDS 3456
#define XB_SPIN_CAP (1u << 18)

__device__ __forceinline__ unsigned xb_ld(unsigned* p)              { return __hip_atomic_load(p, __ATOMIC_RELAXED, __HIP_MEMORY_SCOPE_AGENT); }
__device__ __forceinline__ unsigned xb_add(unsigned* p, unsigned v) { return __hip_atomic_fetch_add(p, v, __ATOMIC_RELAXED, __HIP_MEMORY_SCOPE_AGENT); }
__device__ __forceinline__ unsigned xb_xcc_id() { return (unsigned)__builtin_amdgcn_s_getreg((3 << 11) | 20) & 0xFu; }
#define XB_SPIN(cond, bar) do { unsigned _sp = 0; while (cond) { __builtin_amdgcn_s_sleep(1); \
    if ((++_sp & 255u) == 0u) { if (xb_ld(&(bar)[XB_TMO])) break; if (_sp > XB_SPIN_CAP) { atomicAdd(&(bar)[XB_TMO], 1u); break; } } } } while (0)

struct XcdBarrier {
    unsigned* bar; unsigned x;
    volatile LAS unsigned* st;
};

__device__ __forceinline__ XcdBarrier xcd_barrier_post(unsigned* bar, volatile LAS unsigned* st) {
    XcdBarrier b; b.bar = bar; b.x = xb_xcc_id(); b.st = st;
    if (threadIdx.x == 0) (void)xb_add(&bar[XB_XCNT(b.x)], 1u);
    return b;
}
__device__ __forceinline__ void xcd_barrier_complete(unsigned* bar, unsigned x, unsigned& nloc, unsigned& nx) {
    const unsigned G = gridDim.x * gridDim.y * gridDim.z;
    unsigned sum, cnt, mine, sp = 0u;
    for (;;) {
        sum = 0u; cnt = 0u; mine = 0u;
#pragma unroll
        for (unsigned j = 0; j < 16; ++j) { const unsigned c = xb_ld(&bar[XB_XCNT(j)]); sum += c; cnt += (c > 0u) ? 1u : 0u; mine = (j == x) ? c : mine; }
        if (sum == G) break;
        __builtin_amdgcn_s_sleep(1);
        if ((++sp & 255u) == 0u) { if (xb_ld(&bar[XB_TMO])) break; if (sp > XB_SPIN_CAP) { atomicAdd(&bar[XB_TMO], 1u); break; } }
    }
    nloc = mine > 0u ? mine : 1u; nx = cnt > 0u ? cnt : 1u;
}

__device__ __forceinline__ void xcd_barrier(const XcdBarrier& b) {
    asm volatile("s_waitcnt vmcnt(0)" ::: "memory");
    __syncthreads();
    if (threadIdx.x == 0) {
        unsigned* bar = b.bar;
        __builtin_amdgcn_s_waitcnt(0);
        unsigned nloc = b.st[0], nx = b.st[1];
        if (nloc == 0u) { xcd_barrier_complete(bar, b.x, nloc, nx); b.st[0] = nloc; b.st[1] = nx; }
        const unsigned old = xb_add(&bar[XB_XSUB(b.x)], 1u);
        const unsigned gen = old / nloc;
        if (old + 1u == (gen + 1u) * nloc) {
            __builtin_amdgcn_fence(__ATOMIC_RELEASE, "agent");
            asm volatile("s_waitcnt vmcnt(0)" ::: "memory");
            const unsigned og = xb_add(&bar[XB_TOP], 1u);
            const unsigned tg = og / nx;
            if (og + 1u == (tg + 1u) * nx) xb_add(&bar[XB_TOPGEN], 1u);
            else XB_SPIN(xb_ld(&bar[XB_TOPGEN]) == tg, bar);
            __builtin_amdgcn_fence(__ATOMIC_ACQUIRE, "agent");
            xb_add(&bar[XB_XGEN(b.x)], 1u);
            asm volatile("s_waitcnt vmcnt(0)" ::: "memory");
        } else {
            XB_SPIN(xb_ld(&bar[XB_XGEN(b.x)]) == gen, bar);
            __builtin_amdgcn_fence(__ATOMIC_ACQUIRE, "agent");
            asm volatile("s_waitcnt vmcnt(0)" ::: "memory");
        }
    }
    __syncthreads();
}
__device__ __forceinline__ void xcd_barrier_arrive(const XcdBarrier& b) {
    asm volatile("s_waitcnt vmcnt(0)" ::: "memory");
    __syncthreads();
    if (threadIdx.x == 0) {
        unsigned* bar = b.bar;
        __builtin_amdgcn_s_waitcnt(0);
        unsigned nloc = b.st[0], nx = b.st[1];
        if (nloc == 0u) { xcd_barrier_complete(bar, b.x, nloc, nx); b.st[0] = nloc; b.st[1] = nx; }
        const unsigned old = xb_add(&bar[XB_XSUB(b.x)], 1u);
        const unsigned gen = old / nloc;
        if (old + 1u == (gen + 1u) * nloc) {
            __builtin_amdgcn_fence(__ATOMIC_RELEASE, "agent");
            asm volatile("s_waitcnt vmcnt(0)" ::: "memory");
            const unsigned og = xb_add(&bar[XB_TOP], 1u);
            const unsigned tg = og / nx;
            if (og + 1u == (tg + 1u) * nx) xb_add(&bar[XB_TOPGEN], 1u);
            b.st[2] = 1u; b.st[3] = tg;
        } else { b.st[2] = 0u; b.st[3] = gen; }
    }
}
__device__ __forceinline__ void xcd_barrier_wait(const XcdBarrier& b) {
    __syncthreads();
    if (threadIdx.x == 0) {
        unsigned* bar = b.bar;
        const unsigned lead = b.st[2], g = b.st[3];
        if (lead) {
            XB_SPIN(xb_ld(&bar[XB_TOPGEN]) == g, bar);
            __builtin_amdgcn_fence(__ATOMIC_ACQUIRE, "agent");
            xb_add(&bar[XB_XGEN(b.x)], 1u);
            asm volatile("s_waitcnt vmcnt(0)" ::: "memory");
        } else {
            XB_SPIN(xb_ld(&bar[XB_XGEN(b.x)]) == g, bar);
            __builtin_amdgcn_fence(__ATOMIC_ACQUIRE, "agent");
            asm volatile("s_waitcnt vmcnt(0)" ::: "memory");
        }
    }
    __syncthreads();
}


struct Frame {
    LAS unsigned char* lds;
    volatile LAS unsigned* MISC;
    gu32* ctl;
    int tid, lane, wave;
    int vcu, G;
    unsigned char* ws;
    const float* in[24]; float* out; int rep9;
};
enum { I_X = 0, I_WIN, I_CONVW, I_CONVB, I_WMQ, I_WMK, I_WMGATE, I_BMGATE, I_MNORMG, I_MSKIP, I_LAMQK, I_DANORMG, I_RELBIAS, I_WOUT, I_NORM1G, I_NORM2G, I_WRG, I_BRG, I_WRE, I_BRE, I_WEG, I_WEU, I_WED, I_NORMFG };

__device__ __forceinline__ float wave_sum(float v) {
#pragma unroll
    for (int o = 1; o < 64; o <<= 1) v += __shfl_xor(v, o);
    return v;
}
__device__ __forceinline__ float wave_max(float v) {
#pragma unroll
    for (int o = 1; o < 64; o <<= 1) v = fmaxf(v, __shfl_xor(v, o));
    return v;
}
template <int N> __device__ __forceinline__ float row_shr_f(float fill, float x) { return __builtin_bit_cast(float, __builtin_amdgcn_update_dpp(__builtin_bit_cast(int, fill), __builtin_bit_cast(int, x), 0x110 + N, 0xF, 0xF, false)); }
__device__ __forceinline__ float wave_scan_add(float x, int lane) {
    x += row_shr_f<1>(0.f, x); x += row_shr_f<2>(0.f, x); x += row_shr_f<4>(0.f, x); x += row_shr_f<8>(0.f, x);
    const float t0 = __builtin_bit_cast(float, __builtin_amdgcn_readlane(__builtin_bit_cast(int, x), 15)), t1 = __builtin_bit_cast(float, __builtin_amdgcn_readlane(__builtin_bit_cast(int, x), 31)), t2 = __builtin_bit_cast(float, __builtin_amdgcn_readlane(__builtin_bit_cast(int, x), 47));
    const int row = lane >> 4; return x + (row >= 1 ? t0 : 0.f) + (row >= 2 ? t1 : 0.f) + (row >= 3 ? t2 : 0.f);
}
__device__ __forceinline__ float wave_scan_max(float x, int lane) {
    const float NI = -INFINITY;
    x = fmaxf(x, row_shr_f<1>(NI, x)); x = fmaxf(x, row_shr_f<2>(NI, x)); x = fmaxf(x, row_shr_f<4>(NI, x)); x = fmaxf(x, row_shr_f<8>(NI, x));
    const float t0 = __builtin_bit_cast(float, __builtin_amdgcn_readlane(__builtin_bit_cast(int, x), 15)), t1 = __builtin_bit_cast(float, __builtin_amdgcn_readlane(__builtin_bit_cast(int, x), 31)), t2 = __builtin_bit_cast(float, __builtin_amdgcn_readlane(__builtin_bit_cast(int, x), 47));
    const int row = lane >> 4; return fmaxf(fmaxf(x, row >= 1 ? t0 : NI), fmaxf(row >= 2 ? t1 : NI, row >= 3 ? t2 : NI));
}
__device__ __forceinline__ int t128(int r, int c8) { const int f = ((r & 3) << 1) | ((r >> 2) & 1) | ((((r >> 2) ^ (r >> 3)) & 1) << 3); return r * 256 + ((c8 ^ f) << 4); }
__device__ __forceinline__ int t128e(int r, int c) { return t128(r, c >> 3) + (c & 7) * 2; }

template <bool TRANS> __device__ __forceinline__ void mm128(const LAS unsigned char* A, const LAS unsigned char* B, f32x4 (&acc)[2][4], int wm, int wn, int fr, int fq) {
#pragma unroll
    for (int ks = 0; ks < 4; ++ks) {
        bf16x8 a[2], b[4];
#pragma unroll
        for (int i = 0; i < 2; ++i) a[i] = *(const LAS bf16x8*)(A + t128(wm * 32 + i * 16 + fr, ks * 4 + fq));
#pragma unroll
        for (int j = 0; j < 4; ++j) b[j] = *(const LAS bf16x8*)(B + t128(wn * 64 + j * 16 + fr, ks * 4 + fq));
#pragma unroll
        for (int i = 0; i < 2; ++i)
#pragma unroll
            for (int j = 0; j < 4; ++j) acc[i][j] = TRANS ? __builtin_amdgcn_mfma_f32_16x16x32_bf16(b[j], a[i], acc[i][j], 0, 0, 0) : __builtin_amdgcn_mfma_f32_16x16x32_bf16(a[i], b[j], acc[i][j], 0, 0, 0);
    }
}

typedef short v4i16_t __attribute__((ext_vector_type(4)));
__device__ __forceinline__ bf16x8 frag_tr(const LAS unsigned char* T, int n0, int ks, int lane) {
    const int g = lane >> 4, i = lane & 15, q = i >> 2, p = i & 3, s = 32 * ks + 8 * g + q, ch = (n0 >> 3) + (p >> 1);
    const v4i16_t lo = __builtin_amdgcn_ds_read_tr16_b64_v4i16((LAS v4i16_t*)(T + t128(s, ch) + (p & 1) * 8));
    const v4i16_t hi = __builtin_amdgcn_ds_read_tr16_b64_v4i16((LAS v4i16_t*)(T + t128(s + 4, ch) + (p & 1) * 8));
    return (bf16x8){lo[0], lo[1], lo[2], lo[3], hi[0], hi[1], hi[2], hi[3]};
}
__device__ __forceinline__ v4u xch4(v4u v) { v4u r; r.x = (unsigned)__builtin_amdgcn_mov_dpp((int)v.x, 0xB1, 0xF, 0xF, true); r.y = (unsigned)__builtin_amdgcn_mov_dpp((int)v.y, 0xB1, 0xF, 0xF, true);
    r.z = (unsigned)__builtin_amdgcn_mov_dpp((int)v.z, 0xB1, 0xF, 0xF, true); r.w = (unsigned)__builtin_amdgcn_mov_dpp((int)v.w, 0xB1, 0xF, 0xF, true); return r; }
__device__ __forceinline__ void st_lines(bf16* P, size_t ld, bool odd, v4u w0, v4u w1) {
    const v4u snd = xch4(odd ? w0 : w1); bf16* p = P + (odd ? 8 : 0);
    *(GAS v4u*)p = odd ? snd : w0; *(GAS v4u*)(p + ld) = odd ? w1 : snd;
}
__device__ __forceinline__ int pi64(int c) { return (c & ~63) + 16 * ((c >> 2) & 3) + 4 * ((c >> 4) & 3) + (c & 3); }
__device__ __forceinline__ bf16x8 frag_tr_w(const LAS unsigned char* T, int nb, int j, int ks, int lane) {
    const int g = lane >> 4, i = lane & 15, q = i >> 2, p = i & 3, s = 32 * ks + 8 * g + q, ch = (nb >> 3) + 2 * p + (j >> 1);
    const v4i16_t lo = __builtin_amdgcn_ds_read_tr16_b64_v4i16((LAS v4i16_t*)(T + t128(s, ch) + (j & 1) * 8));
    const v4i16_t hi = __builtin_amdgcn_ds_read_tr16_b64_v4i16((LAS v4i16_t*)(T + t128(s + 4, ch) + (j & 1) * 8));
    return (bf16x8){lo[0], lo[1], lo[2], lo[3], hi[0], hi[1], hi[2], hi[3]};
}
__device__ __forceinline__ void mm128_xb(const LAS unsigned char* A, const LAS unsigned char* X, f32x4 (&acc)[2][4], int wm, int wn, int fr, int fq, int lane) {
#pragma unroll
    for (int ks = 0; ks < 4; ++ks) {
        bf16x8 a[2], b[4];
#pragma unroll
        for (int i = 0; i < 2; ++i) a[i] = *(const LAS bf16x8*)(A + t128(wm * 32 + i * 16 + fr, ks * 4 + fq));
#pragma unroll
        for (int j = 0; j < 4; ++j) b[j] = frag_tr_w(X, wn * 64, j, ks, lane);
#pragma unroll
        for (int i = 0; i < 2; ++i)
#pragma unroll
            for (int j = 0; j < 4; ++j) acc[i][j] = __builtin_amdgcn_mfma_f32_16x16x32_bf16(b[j], a[i], acc[i][j], 0, 0, 0);
    }
}
__device__ __forceinline__ void mm128_xx(const LAS unsigned char* Y, const LAS unsigned char* X, f32x4 (&acc)[2][4], int wm, int wn, int lane) {
#pragma unroll
    for (int ks = 0; ks < 4; ++ks) {
        bf16x8 a[2], b[4];
#pragma unroll
        for (int i = 0; i < 2; ++i) a[i] = frag_tr(Y, wm * 32 + i * 16, ks, lane);
#pragma unroll
        for (int j = 0; j < 4; ++j) b[j] = frag_tr_w(X, wn * 64, j, ks, lane);
#pragma unroll
        for (int i = 0; i < 2; ++i)
#pragma unroll
            for (int j = 0; j < 4; ++j) acc[i][j] = __builtin_amdgcn_mfma_f32_16x16x32_bf16(b[j], a[i], acc[i][j], 0, 0, 0);
    }
}

__device__ __forceinline__ void p0_tr_item(const float* W, int K, int N, bf16* WT, int drow0, LAS float* scr, int kb, int nb, int lane, const float* ksc = nullptr) {
    const int k0 = 64 * kb, n0 = 32 * nb;
    float wv[32];
#pragma unroll
    for (int i = 0; i < 32; ++i) { const int kk = 2 * i + (lane >> 5); wv[i] = __builtin_nontemporal_load(&W[(size_t)(k0 + kk) * N + n0 + (lane & 31)]); }
#pragma unroll
    for (int i = 0; i < 32; ++i) { const int kk = 2 * i + (lane >> 5); scr[kk * 33 + (lane & 31)] = wv[i]; }
    LDS_WAIT(); asm volatile("" ::: "memory");
    const int c = lane & 7;
    f32x4 k0v = (f32x4){1.f, 1.f, 1.f, 1.f}, k1v = k0v; if (ksc) { k0v = *(const GAS f32x4*)(ksc + k0 + 8 * c); k1v = *(const GAS f32x4*)(ksc + k0 + 8 * c + 4); }
#pragma unroll
    for (int j = 0; j < 4; ++j) { const int n = (lane >> 3) + 8 * j; const LAS float* s = scr + (8 * c) * 33 + n;
        v4u o; o.x = pk2(s[0 * 33] * k0v.x, s[1 * 33] * k0v.y); o.y = pk2(s[2 * 33] * k0v.z, s[3 * 33] * k0v.w); o.z = pk2(s[4 * 33] * k1v.x, s[5 * 33] * k1v.y); o.w = pk2(s[6 * 33] * k1v.z, s[7 * 33] * k1v.w);
        *(GAS v4u*)(WT + (size_t)(drow0 + n) * K + k0 + 8 * c) = o; }
    LDS_WAIT(); asm volatile("" ::: "memory");
}
__device__ __forceinline__ void p0_tr_item8(const float* W, int K, int N, unsigned char* WT8, int drow0, LAS float* scr, int kb, int nb, int lane, const float* ksc, float mult) {
    const int k0 = 64 * kb, n0 = 32 * nb;
    float wv[32];
#pragma unroll
    for (int i = 0; i < 32; ++i) { const int kk = 2 * i + (lane >> 5); wv[i] = __builtin_nontemporal_load(&W[(size_t)(k0 + kk) * N + n0 + (lane & 31)]); }
#pragma unroll
    for (int i = 0; i < 32; ++i) { const int kk = 2 * i + (lane >> 5); scr[kk * 33 + (lane & 31)] = wv[i]; }
    LDS_WAIT(); asm volatile("" ::: "memory");
    const int c = lane & 7;
    f32x4 k0v = (f32x4){mult, mult, mult, mult}, k1v = k0v; if (ksc) { k0v = *(const GAS f32x4*)(ksc + k0 + 8 * c) * mult; k1v = *(const GAS f32x4*)(ksc + k0 + 8 * c + 4) * mult; }
#pragma unroll
    for (int j = 0; j < 4; ++j) { const int n = (lane >> 3) + 8 * j; const LAS float* s = scr + (8 * c) * 33 + n;
        const float v[8] = {s[0 * 33] * k0v.x, s[1 * 33] * k0v.y, s[2 * 33] * k0v.z, s[3 * 33] * k0v.w, s[4 * 33] * k1v.x, s[5 * 33] * k1v.y, s[6 * 33] * k1v.z, s[7 * 33] * k1v.w};
        unsigned q0, q1; pg8::pack_fp8x8(v, q0, q1); v2u o; o.x = q0; o.y = q1;
        *(GAS v2u*)(WT8 + (size_t)(drow0 + n) * K + k0 + 8 * c) = o; }
    LDS_WAIT(); asm volatile("" ::: "memory");
}
__device__ __forceinline__ void rms_row_to_bf16(int lane, const float* xrow, const float* g, bf16* orow) {
    const GAS f32x4* xr = (const GAS f32x4*)xrow + lane; const GAS f32x4* gr = (const GAS f32x4*)g + lane;
    f32x4 v[4]; float s = 0.f;
#pragma unroll
    for (int j = 0; j < 4; ++j) { v[j] = xr[64 * j]; s += (v[j].x * v[j].x + v[j].y * v[j].y) + (v[j].z * v[j].z + v[j].w * v[j].w); }
    const float rs = 1.0f / sqrtf(wave_sum(s) * (1.f / D) + EPS_RMS);
    GAS v2u* o8 = (GAS v2u*)orow + lane;
#pragma unroll
    for (int j = 0; j < 4; ++j) { const f32x4 gg = gr[64 * j]; v2u o; o.x = pk2(v[j].x * rs * gg.x, v[j].y * rs * gg.y); o.y = pk2(v[j].z * rs * gg.z, v[j].w * rs * gg.w); o8[64 * j] = o; }
}
typedef const float* cfptr_t;
__device__ __forceinline__ void p_expert_weights(Frame& F, int k_lo = 0, int k_hi = 0x7fff) {
    const __attribute__((address_space(4))) cfptr_t* inp = (const __attribute__((address_space(4))) cfptr_t*)__builtin_amdgcn_kernarg_segment_ptr();
    asm volatile("" : "+s"(inp));
    LAS float* scr = (LAS float*)(F.lds + RING_OFF + F.wave * 16384);
    const int gw = F.vcu * NWAVES + F.wave, NGW = F.G * NWAVES, lane = F.lane;
    unsigned char* ws = F.ws;
    constexpr int IE = NEXP * 256;
    struct It { const float* W; unsigned char* WT8; const float* ksc; int K, N, drow0, k0, n0; };
    auto decode = [&](int it) { It t; int r = it;
        if (r < 2 * IE) { const int up = r >= IE; if (up) r -= IE; const int e = r >> 8, q = r & 255, kb = q >> 4, nb = q & 15, n0 = 32 * nb;
            t.W = inp[up ? I_WEU : I_WEG] + (size_t)e * D * FFE; t.K = D; t.N = FFE; t.WT8 = (unsigned char*)(ws + WS_WGU) + (size_t)e * D * D; t.drow0 = (n0 >> 7) * 256 + (n0 & 127) + (up ? 128 : 0); t.ksc = inp[I_NORM2G]; t.k0 = 64 * kb; t.n0 = n0; }
        else { r -= 2 * IE; const int e = r >> 8, q = r & 255, kb = q >> 5, nb = q & 31;
            t.W = inp[I_WED] + (size_t)e * FFE * D; t.K = FFE; t.N = D; t.WT8 = (unsigned char*)(ws + WS_WD) + (size_t)e * D * FFE; t.drow0 = 32 * nb; t.ksc = nullptr; t.k0 = 64 * kb; t.n0 = 32 * nb; }
        return t; };
#define PEW_LOAD(wv, t) do { _Pragma("unroll") for (int i = 0; i < 32; ++i) { const int kk = 2 * i + (lane >> 5); wv[i] = __builtin_nontemporal_load(&(t).W[(size_t)((t).k0 + kk) * (t).N + (t).n0 + (lane & 31)]); } } while (0)
#define PEW_FINISH(wv, t) do { \
        _Pragma("unroll") for (int i = 0; i < 32; ++i) { const int kk = 2 * i + (lane >> 5); scr[kk * 33 + (lane & 31)] = wv[i]; } \
        LDS_WAIT(); asm volatile("" ::: "memory"); \
        const int c = lane & 7; f32x4 k0v = (f32x4){16.f, 16.f, 16.f, 16.f}, k1v = k0v; \
        if ((t).ksc) { k0v = *(const GAS f32x4*)((t).ksc + (t).k0 + 8 * c) * 16.0f; k1v = *(const GAS f32x4*)((t).ksc + (t).k0 + 8 * c + 4) * 16.0f; } \
        _Pragma("unroll") for (int j = 0; j < 4; ++j) { const int n = (lane >> 3) + 8 * j; const LAS float* sp = scr + (8 * c) * 33 + n; \
            const float v[8] = {sp[0 * 33] * k0v.x, sp[1 * 33] * k0v.y, sp[2 * 33] * k0v.z, sp[3 * 33] * k0v.w, sp[4 * 33] * k1v.x, sp[5 * 33] * k1v.y, sp[6 * 33] * k1v.z, sp[7 * 33] * k1v.w}; \
            unsigned q0, q1; pg8::pack_fp8x8(v, q0, q1); v2u o; o.x = q0; o.y = q1; \
            __builtin_nontemporal_store(o, (GAS v2u*)((t).WT8 + (size_t)((t).drow0 + n) * (t).K + (t).k0 + 8 * c)); } \
        LDS_WAIT(); asm volatile("" ::: "memory"); } while (0)
    float wa[32], wb[32];
    const int lim = (k_hi * NGW < 3 * IE) ? k_hi * NGW : 3 * IE;
    int it = gw + k_lo * NGW; if (it >= lim) return;
    { const It t = decode(it); PEW_LOAD(wa, t); }
    for (;;) {
        const bool hb = it + NGW < lim; if (hb) { const It t = decode(it + NGW); PEW_LOAD(wb, t); }
        { const It t = decode(it); PEW_FINISH(wa, t); } if (!hb) break; it += NGW;
        const bool ha = it + NGW < lim; if (ha) { const It t = decode(it + NGW); PEW_LOAD(wa, t); }
        { const It t = decode(it); PEW_FINISH(wb, t); } if (!ha) break; it += NGW;
    }
#undef PEW_LOAD
#undef PEW_FINISH
}
__device__ __forceinline__ void p0_prologue(Frame& F) {
    LAS float* scr = (LAS float*)(F.lds + RING_OFF + F.wave * 16384);
    const int gw = F.vcu * NWAVES + F.wave, NGW = F.G * NWAVES;
    unsigned char* ws = F.ws;
    constexpr int I0 = 16 * 96, I1 = 16 * 32, IH = NH * 8;
    constexpr int NITEMS = I0 + I1 + 2 * IH;
    for (int it = gw; it < NITEMS; it += NGW) {
        int r = it;
        if (r < I0) { const int nb_ = r % 96;
            if (nb_ >= 16 && nb_ < 48) p0_tr_item8(F.in[I_WIN], D, NPROJ, (unsigned char*)(ws + WS_WIN8), 32 * (nb_ - 16), scr, r / 96, nb_, F.lane, F.in[I_NORM1G], 16.0f);
            else p0_tr_item(F.in[I_WIN], D, NPROJ, (bf16*)(ws + WS_WIN), 32 * (nb_ < 16 ? nb_ : nb_ - 32), scr, r / 96, nb_, F.lane, F.in[I_NORM1G]);
            continue; } r -= I0;
        if (r < I1) { p0_tr_item(F.in[I_WOUT], D, D, (bf16*)(ws + WS_WOUT), 32 * (r % 32), scr, r / 32, r % 32, F.lane); continue; } r -= I1;
        { const int k = r >= IH; if (k) r -= IH; const int h = r >> 3, q = r & 7, kb = q >> 2, nb = q & 3;
            p0_tr_item(F.in[k ? I_WMK : I_WMQ] + (size_t)h * HD * HD, HD, HD, (bf16*)(ws + (k ? WS_WK : WS_WQ)) + (size_t)h * HD * HD, 32 * nb, scr, kb, nb, F.lane); }
    }
    { bf16* wrt = (bf16*)(ws + WS_WR); const float* wrg = F.in[I_WRG]; const float* wre = F.in[I_WRE]; const float* g2 = F.in[I_NORM2G];
      for (int idx = (F.vcu * NWAVES + F.wave) * 64 + F.lane; idx < 48 * D; idx += F.G * NWAVES * 64) { const int p = idx >> 10, k = idx & 1023, j = p >> 4, g = (p >> 2) & 3, r = p & 3;
          float v = 0.f; if (j < 2) v = wre[(size_t)k * 32 + g * 8 + j * 4 + r]; else if (r == 0) v = wrg[(size_t)k * 4 + g];
          wrt[idx] = (bf16)f2bf(v * g2[k]); } }
    { bf16* wct = (bf16*)(ws + WS_WC); const float* wg = F.in[I_WMGATE]; const float* wq = F.in[I_WMQ]; const float* wk = F.in[I_WMK];
      for (int o = gw; o < 8 * DH; o += NGW) { const int g = o >> 9, ch = o & 511, h = ch >> 7, d = ch & 127; float a = 0.f;
#pragma unroll
          for (int eh = 0; eh < 2; ++eh) { const int e = F.lane + 64 * eh; a += wq[(size_t)(h * HD + d) * HD + e] * wg[(size_t)(h * HD + e) * 8 + g] + wk[(size_t)(h * HD + d) * HD + e] * wg[(size_t)(DH + h * HD + e) * 8 + g]; }
          a = wave_sum(a); if (F.lane == 0) wct[g * D + ch] = (bf16)f2bf(a); }
      for (int idx = (F.vcu * NWAVES + F.wave) * 64 + F.lane; idx < 8 * DH; idx += F.G * NWAVES * 64) { const int g = idx >> 9, ch = idx & 511; wct[g * D + DH + ch] = (bf16)f2bf(wg[(size_t)(2 * DH + ch) * 8 + g]); } }
    { bf16* wgt = (bf16*)(ws + WS_WG); const float* wg = F.in[I_WMGATE];
      for (int idx = (F.vcu * NWAVES + F.wave) * 64 + F.lane; idx < 8 * 1536; idx += F.G * NWAVES * 64) { const int g = idx / 1536, j = idx % 1536; wgt[idx] = (bf16)f2bf(wg[j * 8 + g]); } }
    {
        const float* x = F.in[I_X]; bf16* H = (bf16*)(ws + WS_HB); unsigned char* H8 = ws + WS_H8; float* RMS1 = (float*)(ws + SM_RMS1); const int lane = F.lane;
        for (int m0 = gw; m0 < M; m0 += 4 * NGW) {
            f32x4 v[4][4];
#pragma unroll
            for (int q = 0; q < 4; ++q) { const int m = m0 + q * NGW; const GAS f32x4* xr = (const GAS f32x4*)(x + (size_t)(m < M ? m : 0) * D) + lane;
#pragma unroll
                for (int j = 0; j < 4; ++j) v[q][j] = __builtin_nontemporal_load(&xr[64 * j]); }
#pragma unroll
            for (int q = 0; q < 4; ++q) { const int m = m0 + q * NGW; if (m >= M) break;
                float s = 0.f;
#pragma unroll
                for (int j = 0; j < 4; ++j) s += (v[q][j].x * v[q][j].x + v[q][j].y * v[q][j].y) + (v[q][j].z * v[q][j].z + v[q][j].w * v[q][j].w);
                const float rms = sqrtf(wave_sum(s) * (1.f / D) + EPS_RMS), rs = 1.0f / rms; if (lane == 0) RMS1[m] = rms;
                GAS v2u* o8 = (GAS v2u*)(H + (size_t)m * D) + lane; GAS unsigned* o4 = (GAS unsigned*)(H8 + (size_t)m * D) + lane;
#pragma unroll
                for (int j = 0; j < 4; ++j) { const float h0 = v[q][j].x * rs, h1 = v[q][j].y * rs, h2 = v[q][j].z * rs, h3 = v[q][j].w * rs; v2u o; o.x = pk2(h0, h1); o.y = pk2(h2, h3); o8[64 * j] = o;
                    int w8 = 0; w8 = __builtin_amdgcn_cvt_pk_fp8_f32(h0, h1, w8, false); w8 = __builtin_amdgcn_cvt_pk_fp8_f32(h2, h3, w8, true); o4[64 * j] = (unsigned)w8; } }
        }
    }
}

__device__ __forceinline__ void p2_mfront(Frame& F) {
    unsigned char* ws = F.ws;
    const bf16* PC = (const bf16*)(ws + WS_PC); const bf16* PV = (const bf16*)(ws + WS_PV);
    bf16* CA = (bf16*)(ws + WS_CA); bf16* MQ = (bf16*)(ws + WS_MQ); bf16* MK = (bf16*)(ws + WS_MK);
    const bf16* WQT = (const bf16*)(ws + WS_WQ); const bf16* WKT = (const bf16*)(ws + WS_WK); const bf16* WCT = (const bf16*)(ws + WS_WC);
    float* GI = (float*)(ws + SM_GI); float* GF = (float*)(ws + SM_GF);
    const float* convw = F.in[I_CONVW]; const float* convb = F.in[I_CONVB]; const float* bg = F.in[I_BMGATE];
    LAS unsigned char* T_CA = F.lds; LAS unsigned char* T_V = F.lds + 32768; LAS unsigned char* T_Q = F.lds + 65536; LAS unsigned char* T_K = F.lds + 98304;
    LAS float* sCW = (LAS float*)(F.lds + RING_BYTES);
    const int tid0 = F.tid, lane0 = F.lane, wid = F.wave, wm = wid >> 1, wn = wid & 1;
    int tid = tid0, lane = lane0, fr = lane & 15, fq = lane >> 4, c8 = tid & 15, tg = tid >> 4;
    for (int i = tid0; i < 5 * DH / 4; i += NWAVES * 64) *(LAS f32x4*)(sCW + 4 * i) = (i < DH) ? *(const GAS f32x4*)(convw + 4 * i) : *(const GAS f32x4*)(convb + 4 * (i - DH));
    v4u xr[7], vr[4], wqv[4], wkv[4];
#define P2_U(jj) (F.vcu + ((jj) >> 2) * F.G)
#define P2_LOAD(jj) do { const int u_ = P2_U(jj), h_ = (jj) & 3, tok0_ = u_ * CHUNK, s0_ = (u_ % NCH) * CHUNK, col_ = h_ * HD + c8 * 8, t0_ = 4 * tg; \
        _Pragma("unroll") for (int j = 0; j < 7; ++j) { const int tt = t0_ - 3 + j, tc = (s0_ + tt >= 0) ? tt : 0; xr[j] = *(const GAS v4u*)(PC + (size_t)(tok0_ + tc) * DH + col_); }     \
        _Pragma("unroll") for (int j = 0; j < 4; ++j) { vr[j] = *(const GAS v4u*)(PV + (size_t)(tok0_ + t0_ + j) * DH + col_); \
            wqv[j] = *(const GAS v4u*)(WQT + (size_t)h_ * HD * HD + (size_t)(tg + 32 * j) * HD + c8 * 8); wkv[j] = *(const GAS v4u*)(WKT + (size_t)h_ * HD * HD + (size_t)(tg + 32 * j) * HD + c8 * 8); } } while (0)
    __syncthreads();
    if (P2_U(0) < BATCH * NCH) P2_LOAD(0);
    f32x4 gacc = (f32x4){0.f, 0.f, 0.f, 0.f};
    for (int jj = 0; P2_U(jj) < BATCH * NCH; ++jj) {
        const int u = P2_U(jj), h = jj & 3, tok0 = u * CHUNK, s0 = (u % NCH) * CHUNK;
        { int zl = 0; asm volatile("" : "+v"(zl)); tid = tid0 + zl; lane = lane0 + zl; fr = lane & 15; fq = lane >> 4; c8 = tid & 15; tg = tid >> 4; }
        if (h == 0) gacc = (f32x4){0.f, 0.f, 0.f, 0.f};
        {
            const int col = h * HD + c8 * 8, t0 = 4 * tg;
#pragma unroll
            for (int j = 0; j < 4; ++j) { *(LAS v4u*)(T_Q + t128(pi64(tg + 32 * j), c8)) = wqv[j]; *(LAS v4u*)(T_K + t128(pi64(tg + 32 * j), c8)) = wkv[j]; *(LAS v4u*)(T_V + t128(t0 + j, c8)) = vr[j]; }
            f32x4 cw[4][2], cb[2];
#pragma unroll
            for (int j = 0; j < 4; ++j) { cw[j][0] = *(const LAS f32x4*)(sCW + j * DH + col); cw[j][1] = *(const LAS f32x4*)(sCW + j * DH + col + 4); }
            cb[0] = *(const LAS f32x4*)(sCW + 4 * DH + col); cb[1] = *(const LAS f32x4*)(sCW + 4 * DH + col + 4);
#pragma unroll
            for (int q = 0; q < 4; ++q) {
                float a[8] = {cb[0].x, cb[0].y, cb[0].z, cb[0].w, cb[1].x, cb[1].y, cb[1].z, cb[1].w};
#pragma unroll
                for (int j = 0; j < 4; ++j) { v4u xv = xr[q + j]; if (s0 + t0 - 3 + q + j < 0) xv = (v4u){0u, 0u, 0u, 0u}; const f32x4 w0 = cw[j][0], w1 = cw[j][1];
                    a[0] += w0.x * bflo(xv.x); a[1] += w0.y * bfhi(xv.x); a[2] += w0.z * bflo(xv.y); a[3] += w0.w * bfhi(xv.y);
                    a[4] += w1.x * bflo(xv.z); a[5] += w1.y * bfhi(xv.z); a[6] += w1.z * bflo(xv.w); a[7] += w1.w * bfhi(xv.w); }
#pragma unroll
                for (int i = 0; i < 8; ++i) a[i] = a[i] * sigmoidf_(a[i]);
                v4u o; o.x = pk2(a[0], a[1]); o.y = pk2(a[2], a[3]); o.z = pk2(a[4], a[5]); o.w = pk2(a[6], a[7]);
                *(LAS v4u*)(T_CA + t128(t0 + q, c8)) = o;
                *(GAS v4u*)(CA + (size_t)(tok0 + t0 + q) * DH + col) = o;
            }
        }
        bf16x8 wgf[8];
#pragma unroll
        for (int q = 0; q < 8; ++q) wgf[q] = *(const GAS bf16x8*)(WCT + (size_t)(fr & 7) * D + (q >> 2) * DH + h * HD + (q & 3) * 32 + fq * 8);
        asm volatile("" ::: "memory");
        { const int jn = (P2_U(jj + 1) < BATCH * NCH) ? jj + 1 : jj; P2_LOAD(jn); }
        __syncthreads();
        {
            f32x4 aq[2][4], ak[2][4];
#pragma unroll
            for (int i = 0; i < 2; ++i)
#pragma unroll
                for (int j = 0; j < 4; ++j) { aq[i][j] = (f32x4){0.f, 0.f, 0.f, 0.f}; ak[i][j] = (f32x4){0.f, 0.f, 0.f, 0.f}; }
            mm128<true>(T_CA, T_Q, aq, wm, wn, fr, fq);
            mm128<true>(T_CA, T_K, ak, wm, wn, fr, fq);
#pragma unroll
            for (int src = 0; src < 2; ++src) {
                const LAS unsigned char* T = src == 0 ? T_CA : T_V;
#pragma unroll
                for (int ks = 0; ks < 4; ++ks) { const bf16x8 a = *(const LAS bf16x8*)(T + t128(wid * 16 + fr, ks * 4 + fq)); gacc = __builtin_amdgcn_mfma_f32_16x16x32_bf16(a, wgf[src * 4 + ks], gacc, 0, 0, 0); }
            }
#pragma unroll
            for (int i = 0; i < 2; ++i)
                { const int t = wm * 32 + i * 16 + fr, e = wn * 64 + 16 * fq; v4u qv[2], kv[2];
#pragma unroll
                    for (int jp = 0; jp < 2; ++jp) { qv[jp].x = pk2(aq[i][2 * jp][0], aq[i][2 * jp][1]); qv[jp].y = pk2(aq[i][2 * jp][2], aq[i][2 * jp][3]); qv[jp].z = pk2(aq[i][2 * jp + 1][0], aq[i][2 * jp + 1][1]); qv[jp].w = pk2(aq[i][2 * jp + 1][2], aq[i][2 * jp + 1][3]);
                        kv[jp].x = pk2(ak[i][2 * jp][0], ak[i][2 * jp][1]); kv[jp].y = pk2(ak[i][2 * jp][2], ak[i][2 * jp][3]); kv[jp].z = pk2(ak[i][2 * jp + 1][0], ak[i][2 * jp + 1][1]); kv[jp].w = pk2(ak[i][2 * jp + 1][2], ak[i][2 * jp + 1][3]); }
                    st_lines(MQ + (size_t)(tok0 + (t & ~1)) * DH + h * HD + e, DH, fr & 1, qv[0], qv[1]); st_lines(MK + (size_t)(tok0 + (t & ~1)) * DH + h * HD + e, DH, fr & 1, kv[0], kv[1]); }
        }
        if (h == NH - 1 && fr < 8) {
            const float bias = bg[fr];
#pragma unroll
            for (int r = 0; r < 4; ++r) { const int tok = tok0 + wid * 16 + fq * 4 + r; const float v = gacc[r] + bias;
                if (fr < 4) GI[(size_t)tok * 4 + fr] = v; else GF[(size_t)tok * 4 + (fr - 4)] = fminf(v, 0.f) - log1pf(__expf(-fabsf(v))); }
        }
        __syncthreads();
    }
#undef P2_LOAD
#undef P2_U
}

__device__ __forceinline__ void p3_mlocal(Frame& F) {
    unsigned char* ws = F.ws;
    const bf16* PV = (const bf16*)(ws + WS_PV); const bf16* MK = (const bf16*)(ws + WS_MK);
    const float* GI = (const float*)(ws + SM_GI); const float* GF = (const float*)(ws + SM_GF); float* GB = (float*)(ws + SM_GB);
    float* GMAX = (float*)(ws + SM_GMAX); float* BEND = (float*)(ws + SM_BEND); bf16* DC = (bf16*)F.out; float* DN = (float*)(ws + SM_DN);
    LAS unsigned char* T_V = F.lds; LAS unsigned char* T_K = F.lds + 32768; LAS float* sWK = (LAS float*)(F.lds + EX_SM); LAS float* sDN = sWK + 128;
    const int tid0 = F.tid, lane0 = F.lane, wid = F.wave, wm = wid >> 1, wn = wid & 1;
    int tid = tid0, lane = lane0, fr = lane & 15, fq = lane >> 4, c8 = tid & 15, sg = tid >> 4;
    v4u vv4[4], kv4[4]; float f0 = 0.f, f1 = 0.f, i0 = 0.f, i1 = 0.f;
#define P3_LOAD(uu) do { const int c_ = (uu) % NCH, bh_ = (uu) / NCH, h_ = bh_ % NH, b_ = bh_ / NH, tok0_ = b_ * SEQ + c_ * CHUNK; \
        _Pragma("unroll") for (int q = 0; q < 4; ++q) { const size_t go = (size_t)(tok0_ + sg + 32 * q) * DH + h_ * HD + c8 * 8; vv4[q] = *(const GAS v4u*)(PV + go); kv4[q] = *(const GAS v4u*)(MK + go); } \
        if (wid == 0) { f0 = GF[(size_t)(tok0_ + 2 * lane) * 4 + h_]; f1 = GF[(size_t)(tok0_ + 2 * lane + 1) * 4 + h_]; i0 = GI[(size_t)(tok0_ + 2 * lane) * 4 + h_]; i1 = GI[(size_t)(tok0_ + 2 * lane + 1) * 4 + h_]; } } while (0)
#define P3_U(jj) (F.vcu + ((jj) >> 2) * F.G)
#define P3_U3(jj) ((((P3_U(jj) >> 5) * NH + ((jj) & 3)) * NCH) + (P3_U(jj) & 31))
    asm volatile("s_waitcnt vmcnt(0)" ::: "memory"); __syncthreads();
    if (tid0 == 0) { __builtin_amdgcn_fence(__ATOMIC_ACQUIRE, "agent"); asm volatile("s_waitcnt vmcnt(0)" ::: "memory"); }
    __syncthreads();
    int jj = 0;
    if (P3_U(0) < BATCH * NCH) P3_LOAD(P3_U3(0));
    for (; P3_U(jj) < BATCH * NCH; ++jj) {
        const int u3 = P3_U3(jj);
        const int c = u3 % NCH, bh = u3 / NCH, h = bh % NH, b = bh / NH, tok0 = b * SEQ + c * CHUNK;
        { int zl = 0; asm volatile("" : "+v"(zl)); tid = tid0 + zl; lane = lane0 + zl; fr = lane & 15; fq = lane >> 4; c8 = tid & 15; sg = tid >> 4; }
        if (wid == 0) {
            const float incl = wave_scan_add(f0 + f1, lane);
            const float b1 = incl, b0 = incl - f1, bend = __shfl(incl, 63);
            GB[(size_t)(tok0 + 2 * lane) * 4 + h] = b0; GB[(size_t)(tok0 + 2 * lane + 1) * 4 + h] = b1;
            const float g0 = bend - b0 + i0, g1 = bend - b1 + i1, gm = wave_max(fmaxf(g0, g1));
            sWK[2 * lane] = __expf(g0 - gm) * KSCALE; sWK[2 * lane + 1] = __expf(g1 - gm) * KSCALE;
            if (lane == 0) { GMAX[u3] = gm; BEND[u3] = bend; }
        }
#pragma unroll
        for (int q = 0; q < 4; ++q) *(LAS v4u*)(T_V + t128(sg + 32 * q, c8)) = vv4[q];
        __syncthreads();
#pragma unroll
        for (int q = 0; q < 4; ++q) { const int s = sg + 32 * q; const float wk = sWK[s]; const v4u kv = kv4[q];
            v4u o; o.x = pk2(bflo(kv.x) * wk, bfhi(kv.x) * wk); o.y = pk2(bflo(kv.y) * wk, bfhi(kv.y) * wk); o.z = pk2(bflo(kv.z) * wk, bfhi(kv.z) * wk); o.w = pk2(bflo(kv.w) * wk, bfhi(kv.w) * wk);
            *(LAS v4u*)(T_K + t128(s, c8)) = o; }
        { const int jn = (P3_U(jj + 1) < BATCH * NCH) ? jj + 1 : jj; P3_LOAD(P3_U3(jn)); }
        __syncthreads();
        {
            f32x4 acc[2][4];
#pragma unroll
            for (int i = 0; i < 2; ++i)
#pragma unroll
                for (int j = 0; j < 4; ++j) acc[i][j] = (f32x4){0.f, 0.f, 0.f, 0.f};
            mm128_xx(T_V, T_K, acc, wm, wn, lane);
            bf16* dc = DC + (size_t)u3 * HD * HD;
#pragma unroll
            for (int i = 0; i < 2; ++i)
                { v4u ov[2];
#pragma unroll
                    for (int jp = 0; jp < 2; ++jp) { ov[jp].x = pk2(acc[i][2 * jp][0], acc[i][2 * jp][1]); ov[jp].y = pk2(acc[i][2 * jp][2], acc[i][2 * jp][3]); ov[jp].z = pk2(acc[i][2 * jp + 1][0], acc[i][2 * jp + 1][1]); ov[jp].w = pk2(acc[i][2 * jp + 1][2], acc[i][2 * jp + 1][3]); }
                    st_lines(dc + (size_t)(wm * 32 + i * 16 + (fr & ~1)) * HD + wn * 64 + 16 * fq, HD, fr & 1, ov[0], ov[1]); }
        }
        { const int kk = tid & 127, sq = tid >> 7; float sm = 0.f;
#pragma unroll 8
            for (int r = 0; r < 32; ++r) sm += bf1(*(const LAS unsigned short*)(T_K + t128e(sq * 32 + r, kk)));
            sDN[sq * 128 + kk] = sm; }
        __syncthreads();
        if (tid < HD) DN[(size_t)u3 * HD + tid] = (sDN[tid] + sDN[128 + tid]) + (sDN[256 + tid] + sDN[384 + tid]);
    }
#undef P3_LOAD
#undef P3_U
#undef P3_U3
}

__device__ __forceinline__ void p4_mscan(Frame& F) {
    unsigned char* ws = F.ws;
    const float* GMAX = (const float*)(ws + SM_GMAX); const float* BEND = (const float*)(ws + SM_BEND); const bf16* DC = (const bf16*)F.out; const float* DN = (const float*)(ws + SM_DN);
    float* MPREV = (float*)(ws + SM_MPREV); float* NP = (float*)(ws + SM_NP); bf16* CP = (bf16*)(ws + WS_CP);
    const int gt = (F.vcu * NWAVES + F.wave) * 64 + F.lane, NT = F.G * NWAVES * 64;
    for (int gid = gt; gid < BATCH * NH * 4096; gid += NT) {
        const int bh = gid >> 12, e4 = gid & 4095;
        float m = 0.f; f32x4 C = (f32x4){0.f, 0.f, 0.f, 0.f};
        for (int c0 = 0; c0 < NCH; c0 += 8) {
            f32x4 d[8]; float be[8], gm[8];
#pragma unroll
            for (int q = 0; q < 8; ++q) { const int u3 = bh * NCH + c0 + q; { const v2u w = __builtin_nontemporal_load((const GAS v2u*)(DC + (size_t)u3 * HD * HD + e4 * 4)); d[q] = (f32x4){bflo(w.x), bfhi(w.x), bflo(w.y), bfhi(w.y)}; } be[q] = BEND[u3]; gm[q] = GMAX[u3]; }
#pragma unroll
            for (int q = 0; q < 8; ++q) { const int u3 = bh * NCH + c0 + q;
                v2u o; o.x = pk2(C.x, C.y); o.y = pk2(C.z, C.w);
                *(GAS v2u*)(CP + (size_t)u3 * HD * HD + e4 * 4) = o;
                if (e4 == 0) MPREV[u3] = m;
                const float mn = fmaxf(be[q] + m, gm[q]), dec = __expf(be[q] + m - mn), sl = __expf(gm[q] - mn);
                C = C * dec + d[q] * sl; m = mn; }
        }
    }
    for (int gid = gt; gid < BATCH * NH * HD; gid += NT) {
        const int bh = gid >> 7, k = gid & 127;
        float m = 0.f, n = 0.f;
        for (int c = 0; c < NCH; ++c) {
            const int u3 = bh * NCH + c;
            NP[(size_t)u3 * HD + k] = n;
            const float be = BEND[u3], gm = GMAX[u3], mn = fmaxf(be + m, gm), dec = __expf(be + m - mn), sl = __expf(gm - mn);
            n = n * dec + DN[(size_t)u3 * HD + k] * sl; m = mn;
        }
    }
}

__device__ __forceinline__ void p5_mout(Frame& F, const XcdBarrier bar, const bool split, int ka, int kb) {
    unsigned char* ws = F.ws;
    const bf16* PV = (const bf16*)(ws + WS_PV); const bf16* PZ = (const bf16*)(ws + WS_PZ); const bf16* MQ = (const bf16*)(ws + WS_MQ); const bf16* MK = (const bf16*)(ws + WS_MK);
    const bf16* CA = (const bf16*)(ws + WS_CA); const bf16* CP = (const bf16*)(ws + WS_CP); bf16* A2 = (bf16*)((unsigned char*)F.out + OUT_A2);
    const float* GI = (const float*)(ws + SM_GI); const float* GB = (const float*)(ws + SM_GB); const float* MPREV = (const float*)(ws + SM_MPREV); const float* NP = (const float*)(ws + SM_NP);
    const float* ng = F.in[I_MNORMG]; const float* skip = F.in[I_MSKIP];
    LAS unsigned char* T_Q = F.lds; LAS unsigned char* T_K = F.lds + 32768; LAS unsigned char* T_VT = F.lds + 65536; LAS unsigned char* T_CP = F.lds + 98304;
    LAS float* sA = (LAS float*)(F.lds + EX_SM); LAS float* sB = sA + 128; LAS float* sM = sA + 256; LAS float* sSP = sA + 384; LAS float* sINV = sA + 512; LAS float* sNP = sA + 640; LAS float* sPart = sA + 768;
    const int tid0 = F.tid, lane0 = F.lane, wid = F.wave, wm = wid >> 1, wn = wid & 1;
    int tid = tid0, lane = lane0, fr = lane & 15, fq = lane >> 4, c8 = tid & 15, rg = tid >> 4;
    LAS float* sNG = (LAS float*)(F.lds + EXB);
    for (int i = tid0; i < 2 * DH / 4; i += NWAVES * 64) *(LAS f32x4*)(sNG + 4 * i) = (i < DH / 4) ? *(const GAS f32x4*)(ng + 4 * i) : *(const GAS f32x4*)(skip + 4 * (i - DH / 4));
    v4u q4[4], k4[4], c4[4], v4[4]; float gb0 = 0.f, gb1 = 0.f, gi0 = 0.f, gi1 = 0.f, np0 = 0.f, np1 = 0.f, mprev_n = 0.f;
#define P5_LOAD_A(uu) do { const int c_ = (uu) % NCH, bh_ = (uu) / NCH, h_ = bh_ % NH, b_ = bh_ / NH, tok0_ = b_ * SEQ + c_ * CHUNK;     \
        _Pragma("unroll") for (int q = 0; q < 4; ++q) { const int r = rg + 32 * q; const size_t go = (size_t)(tok0_ + r) * DH + h_ * HD + c8 * 8; \
            q4[q] = __builtin_nontemporal_load((const GAS v4u*)(MQ + go)); k4[q] = __builtin_nontemporal_load((const GAS v4u*)(MK + go)); v4[q] = __builtin_nontemporal_load((const GAS v4u*)(PV + go)); } \
        if (wid == 0) { gb0 = GB[(size_t)(tok0_ + 2 * lane) * 4 + h_]; gb1 = GB[(size_t)(tok0_ + 2 * lane + 1) * 4 + h_]; gi0 = GI[(size_t)(tok0_ + 2 * lane) * 4 + h_]; gi1 = GI[(size_t)(tok0_ + 2 * lane + 1) * 4 + h_]; } } while (0)
#define P5_LOAD_B(uu) do {     \
        _Pragma("unroll") for (int q = 0; q < 4; ++q) { const int r = rg + 32 * q; c4[q] = __builtin_nontemporal_load((const GAS v4u*)(CP + (size_t)(uu) * HD * HD + r * HD + c8 * 8)); } \
        mprev_n = MPREV[(uu)]; \
        if (wid == 1) { np0 = NP[(size_t)(uu) * HD + lane]; np1 = NP[(size_t)(uu) * HD + lane + 64]; } } while (0)
#define P5_LOAD(uu) do { P5_LOAD_A(uu); P5_LOAD_B(uu); } while (0)
    int u3 = F.vcu;
    if (split) {
        xcd_barrier_arrive(bar);
        p_expert_weights(F, ka, kb);
        if (u3 < NU3) P5_LOAD_A(u3);
        xcd_barrier_wait(bar);
        if (u3 < NU3) P5_LOAD_B(u3);
    } else if (u3 < NU3) P5_LOAD(u3);
    for (; u3 < NU3; u3 += F.G) {
        const int c = u3 % NCH, bh = u3 / NCH, h = bh % NH, b = bh / NH, tok0 = b * SEQ + c * CHUNK;
        { int zl = 0; asm volatile("" : "+v"(zl)); tid = tid0 + zl; lane = lane0 + zl; fr = lane & 15; fq = lane >> 4; c8 = tid & 15; rg = tid >> 4; }
#pragma unroll
        for (int q = 0; q < 4; ++q) { const int r = rg + 32 * q;
            *(LAS v4u*)(T_Q + t128(r, c8)) = q4[q]; *(LAS v4u*)(T_K + t128(r, c8)) = k4[q]; *(LAS v4u*)(T_CP + t128(pi64(r), c8)) = c4[q]; *(LAS v4u*)(T_VT + t128(r, c8)) = v4[q]; }
        const float mprev = mprev_n;
        if (wid == 0) {
            const float b0 = gb0, b1 = gb1, a0 = gi0 - b0, a1 = gi1 - b1;
            const float incl = wave_scan_max(fmaxf(a0, a1), lane);
            float excl = __shfl_up(incl, 1); if (lane == 0) excl = -INFINITY;
            const float M0 = fmaxf(fmaxf(mprev, excl), a0), M1 = fmaxf(M0, a1);
            sA[2 * lane] = a0; sA[2 * lane + 1] = a1; sB[2 * lane] = b0; sB[2 * lane + 1] = b1; sM[2 * lane] = M0; sM[2 * lane + 1] = M1;
            sSP[2 * lane] = __expf(mprev - M0); sSP[2 * lane + 1] = __expf(mprev - M1);
        } else if (wid == 1) { sNP[lane] = np0; sNP[lane + 64] = np1; }
        { const int un = (u3 + F.G < NU3) ? u3 + F.G : u3; P5_LOAD(un); }
        __syncthreads();
        f32x4 acc[2][4];
        {
            f32x4 accS[2][4];
#pragma unroll
            for (int i = 0; i < 2; ++i)
#pragma unroll
                for (int j = 0; j < 4; ++j) { accS[i][j] = (f32x4){0.f, 0.f, 0.f, 0.f}; acc[i][j] = (f32x4){0.f, 0.f, 0.f, 0.f}; }
            mm128<true>(T_Q, T_K, accS, wm, wn, fr, fq);
            mm128<true>(T_Q, T_CP, acc, wm, wn, fr, fq);
            __syncthreads();
#pragma unroll
            for (int i = 0; i < 2; ++i) { const int t = wm * 32 + i * 16 + fr; const float Mt = sM[t];
#pragma unroll
                for (int j = 0; j < 4; ++j) { const int s = wn * 64 + j * 16 + fq * 4; float w[4];
#pragma unroll
                    for (int r = 0; r < 4; ++r) w[r] = (s + r <= t) ? accS[i][j][r] * KSCALE * __expf(sA[s + r] - Mt) : 0.f;
                    v2u o; o.x = pk2(w[0], w[1]); o.y = pk2(w[2], w[3]); *(LAS v2u*)(T_K + t128e(t, s)) = o; } }
        }
        __syncthreads();
        v4u cw[2][2], zw[2][2];
#pragma unroll
        for (int i = 0; i < 2; ++i)
            { const bool odd = fr & 1; const size_t ga = (size_t)(tok0 + wm * 32 + i * 16 + (fr & ~1)) * DH + h * HD + wn * 64 + 16 * fq + (odd ? 8 : 0), gb = ga + DH;
                const v4u ca = __builtin_nontemporal_load((const GAS v4u*)(CA + ga)), cb = __builtin_nontemporal_load((const GAS v4u*)(CA + gb)), za = __builtin_nontemporal_load((const GAS v4u*)(PZ + ga)), zb = __builtin_nontemporal_load((const GAS v4u*)(PZ + gb));
                cw[i][0] = ca; cw[i][1] = cb; zw[i][0] = za; zw[i][1] = zb; }
        {
            const int t = tid >> 2, qd = tid & 3; float rs = 0.f, qn = 0.f;
#pragma unroll
            for (int cc = 0; cc < 4; ++cc) { const int ch = qd * 4 + cc; const v4u w = *(const LAS v4u*)(T_K + t128(t, ch)); const v4u q = *(const LAS v4u*)(T_Q + t128(t, ch));
                rs += (bflo(w.x) + bfhi(w.x)) + (bflo(w.y) + bfhi(w.y)) + (bflo(w.z) + bfhi(w.z)) + (bflo(w.w) + bfhi(w.w));
                const LAS float* np = sNP + ch * 8;
                qn += bflo(q.x) * np[0] + bfhi(q.x) * np[1] + bflo(q.y) * np[2] + bfhi(q.y) * np[3] + bflo(q.z) * np[4] + bfhi(q.z) * np[5] + bflo(q.w) * np[6] + bfhi(q.w) * np[7]; }
            rs += __shfl_xor(rs, 1); rs += __shfl_xor(rs, 2); qn += __shfl_xor(qn, 1); qn += __shfl_xor(qn, 2);
            if (qd == 0) { const float den = sSP[t] * qn + rs, mt = sB[t] + sM[t]; sINV[t] = 1.0f / fmaxf(fabsf(den), __expf(-mt)); }
        }
#pragma unroll
        for (int i = 0; i < 2; ++i) { const float sp = sSP[wm * 32 + i * 16 + fr];
#pragma unroll
            for (int j = 0; j < 4; ++j) acc[i][j] = acc[i][j] * sp; }
        mm128_xb(T_K, T_VT, acc, wm, wn, fr, fq, lane);
        __syncthreads();
#pragma unroll
        for (int i = 0; i < 2; ++i) { const int t = wm * 32 + i * 16 + fr; const float inv = sINV[t]; float s1 = 0.f, s2 = 0.f;
#pragma unroll
            for (int j = 0; j < 4; ++j) { acc[i][j] = acc[i][j] * inv;
#pragma unroll
                for (int r = 0; r < 4; ++r) { s1 += acc[i][j][r]; s2 += acc[i][j][r] * acc[i][j][r]; } }
            s1 += __shfl_xor(s1, 16); s1 += __shfl_xor(s1, 32); s2 += __shfl_xor(s2, 16); s2 += __shfl_xor(s2, 32);
            if (fq == 0) { sPart[(t * 2 + wn) * 2] = s1; sPart[(t * 2 + wn) * 2 + 1] = s2; } }
        __syncthreads();
        f32x4 gv[4], kv4[4];
#pragma unroll
        for (int q4 = 0; q4 < 4; ++q4) { const int c_ = h * HD + wn * 64 + 16 * fq + 4 * q4; gv[q4] = *(const LAS f32x4*)(sNG + c_); kv4[q4] = *(const LAS f32x4*)(sNG + DH + c_); }
#pragma unroll
        for (int i = 0; i < 2; ++i) { const int t = wm * 32 + i * 16 + fr;
            { const bool odd = fr & 1; const v4u rc = xch4(odd ? cw[i][0] : cw[i][1]), rz = xch4(odd ? zw[i][0] : zw[i][1]);
              const v4u c0v = odd ? rc : cw[i][0], c1v = odd ? cw[i][1] : rc, z0v = odd ? rz : zw[i][0], z1v = odd ? zw[i][1] : rz; cw[i][0] = c0v; cw[i][1] = c1v; zw[i][0] = z0v; zw[i][1] = z1v; }
            const float s1 = sPart[t * 4] + sPart[t * 4 + 2], s2 = sPart[t * 4 + 1] + sPart[t * 4 + 3];
            const float mu = s1 * (1.f / HD), var = fmaxf(s2 * (1.f / HD) - mu * mu, 0.f), rstd = 1.0f / sqrtf(var + EPS_RMS);
            v4u ov[2];
#pragma unroll
            for (int jp = 0; jp < 2; ++jp) { const int col = h * HD + wn * 64 + 16 * fq + 8 * jp; v4u o;
#pragma unroll
                for (int jj = 0; jj < 2; ++jj) { const int j = 2 * jp + jj;
                    const unsigned c0 = jj ? cw[i][jp].z : cw[i][jp].x, c1 = jj ? cw[i][jp].w : cw[i][jp].y, z0 = jj ? zw[i][jp].z : zw[i][jp].x, z1 = jj ? zw[i][jp].w : zw[i][jp].y;
                    const f32x4 g4 = gv[2 * jp + jj], k4v = kv4[2 * jp + jj];
                    const float y0 = (acc[i][j][0] - mu) * rstd * g4.x + k4v.x * bflo(c0), y1 = (acc[i][j][1] - mu) * rstd * g4.y + k4v.y * bfhi(c0);
                    const float y2 = (acc[i][j][2] - mu) * rstd * g4.z + k4v.z * bflo(c1), y3 = (acc[i][j][3] - mu) * rstd * g4.w + k4v.w * bfhi(c1);
                    const unsigned o0 = pk2(y0 * bflo(z0), y1 * bfhi(z0)), o1 = pk2(y2 * bflo(z1), y3 * bfhi(z1));
                    if (jj == 0) { o.x = o0; o.y = o1; } else { o.z = o0; o.w = o1; } }
                ov[jp] = o; }
            st_lines(A2 + (size_t)(tok0 + (t & ~1)) * D + h * HD + wn * 64 + 16 * fq, D, fr & 1, ov[0], ov[1]); }
        __syncthreads();
    }
#undef P5_LOAD
#undef P5_LOAD_A
#undef P5_LOAD_B
}

__device__ __forceinline__ void build_dltab(Frame& F) {
    LAS float* dl = (LAS float*)(F.lds + EX_DL); const float* rb = F.in[I_RELBIAS];
    for (int idx = F.tid; idx < 4 * 640; idx += NWAVES * 64) {
        const int h = idx / 640, n = idx % 640 - 256; float v = 0.f;
        if (n < 0) v = -1.0e30f;
        else if (n < 128) {
            int bk;
            if (n < 16) bk = n; else { bk = 16 + (int)(logf((float)n / 16.0f) / 2.0794415416798357f * 16.0f); bk = bk > 31 ? 31 : bk; }
            v = (rb[bk * 4 + h] - rb[31 * 4 + h]) * LOG2E;
        }
        dl[idx] = v;
    }
}
__device__ __forceinline__ void p7_combine(Frame& F) {
    const bf16* AO = (const bf16*)F.out; bf16* A2 = (bf16*)((unsigned char*)F.out + OUT_A2);
    const float* lq = F.in[I_LAMQK]; const float* dg = F.in[I_DANORMG];
    const int lane = F.lane, gw = F.vcu * NWAVES + F.wave, NGW = F.G * NWAVES;
    const float sa = wave_sum(lq[lane] * lq[64 + lane]), sb = wave_sum(lq[128 + lane] * lq[192 + lane]);
    const float lam = __expf(sa) - __expf(sb) + LAM_INIT;
    const int dcol = (lane & 15) * 8;
    const f32x4 g0 = *(const GAS f32x4*)(dg + dcol), g1 = *(const GAS f32x4*)(dg + dcol + 4);
    for (int tok = gw; tok < M; tok += NGW) {
        const v4u a = __builtin_nontemporal_load((const GAS v4u*)(AO + (size_t)tok * D + lane * 8)), bb = __builtin_nontemporal_load((const GAS v4u*)(AO + (size_t)tok * D + DH + lane * 8));
        float y[8];
        y[0] = bflo(a.x) - lam * bflo(bb.x); y[1] = bfhi(a.x) - lam * bfhi(bb.x); y[2] = bflo(a.y) - lam * bflo(bb.y); y[3] = bfhi(a.y) - lam * bfhi(bb.y);
        y[4] = bflo(a.z) - lam * bflo(bb.z); y[5] = bfhi(a.z) - lam * bfhi(bb.z); y[6] = bflo(a.w) - lam * bflo(bb.w); y[7] = bfhi(a.w) - lam * bfhi(bb.w);
        float ss = 0.f;
#pragma unroll
        for (int i = 0; i < 8; ++i) ss += y[i] * y[i];
        ss += __shfl_xor(ss, 1); ss += __shfl_xor(ss, 2); ss += __shfl_xor(ss, 4); ss += __shfl_xor(ss, 8);
        const float rs = (1.0f - LAM_INIT) / sqrtf(ss * (1.f / 128.f) + EPS_SUB);
        v4u o; o.x = pk2(y[0] * rs * g0.x, y[1] * rs * g0.y); o.y = pk2(y[2] * rs * g0.z, y[3] * rs * g0.w); o.z = pk2(y[4] * rs * g1.x, y[5] * rs * g1.y); o.w = pk2(y[6] * rs * g1.z, y[7] * rs * g1.w);
        *(GAS v4u*)(A2 + (size_t)tok * D + DH + lane * 8) = o;
    }
}
__device__ __forceinline__ void p7_local(Frame& F, int b, int head, int qb) {
    const bf16* AO = (const bf16*)F.out; bf16* A2 = (bf16*)((unsigned char*)F.out + OUT_A2);
    const float* lq = F.in[I_LAMQK]; const float* dg = F.in[I_DANORMG];
    const int lane = F.lane;
    const float sa = wave_sum(lq[lane] * lq[64 + lane]), sb = wave_sum(lq[128 + lane] * lq[192 + lane]);
    const float lam = __expf(sa) - __expf(sb) + LAM_INIT;
    const int dcol = (lane & 15) * 8;
    const f32x4 g0 = *(const GAS f32x4*)(dg + dcol), g1 = *(const GAS f32x4*)(dg + dcol + 4);
    const size_t row0 = (size_t)b * SEQ + (size_t)qb * 256 + F.wave * 32 + (lane >> 4);
#pragma nounroll
    for (int h4 = 0; h4 < 2; ++h4) {
    v4u av[4], bv[4];
#pragma unroll
    for (int it = 0; it < 4; ++it) { const size_t tok = row0 + (h4 * 4 + it) * 4; av[it] = *(const GAS v4u*)(AO + tok * D + head * HD + dcol); bv[it] = *(const GAS v4u*)(AO + tok * D + DH + head * HD + dcol); }
#pragma unroll
    for (int it = 0; it < 4; ++it) { const size_t tok = row0 + (h4 * 4 + it) * 4; const v4u a = av[it], bb = bv[it];
        float y[8];
        y[0] = bflo(a.x) - lam * bflo(bb.x); y[1] = bfhi(a.x) - lam * bfhi(bb.x); y[2] = bflo(a.y) - lam * bflo(bb.y); y[3] = bfhi(a.y) - lam * bfhi(bb.y);
        y[4] = bflo(a.z) - lam * bflo(bb.z); y[5] = bfhi(a.z) - lam * bfhi(bb.z); y[6] = bflo(a.w) - lam * bflo(bb.w); y[7] = bfhi(a.w) - lam * bfhi(bb.w);
        float ss = 0.f;
#pragma unroll
        for (int i = 0; i < 8; ++i) ss += y[i] * y[i];
        ss += __shfl_xor(ss, 1); ss += __shfl_xor(ss, 2); ss += __shfl_xor(ss, 4); ss += __shfl_xor(ss, 8);
        const float rs = (1.0f - LAM_INIT) / sqrtf(ss * (1.f / 128.f) + EPS_SUB);
        v4u o; o.x = pk2(y[0] * rs * g0.x, y[1] * rs * g0.y); o.y = pk2(y[2] * rs * g0.z, y[3] * rs * g0.w); o.z = pk2(y[4] * rs * g1.x, y[5] * rs * g1.y); o.w = pk2(y[6] * rs * g1.z, y[7] * rs * g1.w);
        *(GAS v4u*)(A2 + tok * D + DH + head * HD + dcol) = o; }
    }
}
__device__ __forceinline__ void p9_prep(Frame& F) {
    LAS unsigned char* WL = F.lds; const bf16* WRT = (const bf16*)(F.ws + WS_WR);
    for (int c = F.tid; c < 48 * 128; c += NWAVES * 64) { const int p = c >> 7, ch = c & 127; *(LAS v4u*)(WL + p * 2048 + ((ch ^ (p & 15)) << 4)) = *(const GAS v4u*)(WRT + (size_t)p * D + ch * 8); }
}
__device__ __forceinline__ void p9_router(Frame& F, bool prepped) {
    const bf16* X1B = (const bf16*)(F.ws + WS_X1B); float* RSROW = (float*)(F.ws + WS_RS); LAS float* sRS = (LAS float*)(F.lds + EX_SM);
    const float* brg = F.in[I_BRG]; const float* bre = F.in[I_BRE];
    int* EID = (int*)(F.ws + SM_EID); float* GATE = (float*)(F.ws + SM_GATE); int* POSR = (int*)(F.ws + SM_POS); int* ROWTOK = (int*)(F.ws + WS_RT);
    LAS int* lcnt = (LAS int*)(F.lds + EX_HIST); LAS int* lbase = lcnt + 32; LAS int* sE = (LAS int*)(F.lds + EX_ROW);
    const int lane = F.lane, gw = F.vcu * NWAVES + F.wave, NGW = F.G * NWAVES;
    LAS unsigned char* WL = F.lds;
    if (!prepped) p9_prep(F);
    if (F.tid < 32) lcnt[F.tid] = 0;
    __syncthreads();
    for (int itx = 0; itx < F.rep9; ++itx) {
        const int ti = lane & 15, fq = lane >> 4, tok = gw + ti * NGW;
        const bf16* xrow = X1B + (size_t)tok * D + fq * 8;
        f32x4 acc[3]; acc[0] = (f32x4){0.f, 0.f, 0.f, 0.f}; acc[1] = acc[0]; acc[2] = acc[0]; float ss = 0.f;
#pragma unroll 8
        for (int ks = 0; ks < 32; ++ks) {
            const v4u aw = *(const GAS v4u*)(xrow + ks * 32); const bf16x8 a = __builtin_bit_cast(bf16x8, aw);
            ss += (bflo(aw.x) * bflo(aw.x) + bfhi(aw.x) * bfhi(aw.x)) + (bflo(aw.y) * bflo(aw.y) + bfhi(aw.y) * bfhi(aw.y)) + (bflo(aw.z) * bflo(aw.z) + bfhi(aw.z) * bfhi(aw.z)) + (bflo(aw.w) * bflo(aw.w) + bfhi(aw.w) * bfhi(aw.w));
#pragma unroll
            for (int j = 0; j < 3; ++j) { const int p = 16 * j + ti; const bf16x8 b = *(const LAS bf16x8*)(WL + p * 2048 + (((ks * 4 + fq) ^ (p & 15)) << 4)); acc[j] = __builtin_amdgcn_mfma_f32_16x16x32_bf16(b, a, acc[j], 0, 0, 0); }
        }
        ss += __shfl_xor(ss, 16); ss += __shfl_xor(ss, 32);
        const float rs = 1.0f / sqrtf(ss * (1.f / D) + EPS_RMS);
        const float lgm = acc[2][0] * rs + brg[fq];
        float mv = lgm; int mg = fq;
#pragma unroll
        for (int o = 16; o <= 32; o <<= 1) { const float ov = __shfl_xor(mv, o); const int og = __shfl_xor(mg, o); if (ov > mv || (ov == mv && og < mg)) { mv = ov; mg = og; } }
        float se = __expf(lgm - mv); se += __shfl_xor(se, 16); se += __shfl_xor(se, 32);
        if (fq == mg) {
            const float pgsel = 1.0f / se;
            float le[8];
#pragma unroll
            for (int e = 0; e < 8; ++e) le[e] = acc[e >> 2][e & 3] * rs + bre[fq * 8 + e];
            int i1 = 0; float v1 = le[0];
#pragma unroll
            for (int i = 1; i < 8; ++i) if (le[i] > v1) { v1 = le[i]; i1 = i; }
            int i2 = -1; float v2 = -INFINITY;
#pragma unroll
            for (int i = 0; i < 8; ++i) if (i != i1 && le[i] > v2) { v2 = le[i]; i2 = i; }
            const float p1 = 1.0f / (1.0f + __expf(v2 - v1)), p2 = 1.0f - p1;
            const int lt = F.wave * 16 + ti; sE[lt * 2] = fq * 8 + i1; sE[lt * 2 + 1] = fq * 8 + i2; sRS[lt] = rs; GATE[(size_t)tok * 2] = pgsel * p1; GATE[(size_t)tok * 2 + 1] = pgsel * p2;
        }
    }
    __syncthreads();
    int e = 0, rank = 0;
    if (F.tid < 256) { e = sE[F.tid]; rank = __hip_atomic_fetch_add(lcnt + e, 1, __ATOMIC_RELAXED, __HIP_MEMORY_SCOPE_WORKGROUP); }
    __syncthreads();
    if (F.tid < 32) lbase[F.tid] = (int)__hip_atomic_fetch_add(F.ctl + CW_CUR + F.tid, (unsigned)lcnt[F.tid], RLX_AGENT);
    __syncthreads();
    if (F.tid < 256) { const int lt = F.tid >> 1, tok = F.vcu * NWAVES + (lt >> 4) + (lt & 15) * NGW, r = lbase[e] + rank;
        EID[(size_t)tok * 2 + (F.tid & 1)] = e; POSR[(size_t)tok * 2 + (F.tid & 1)] = r; ROWTOK[(size_t)e * RT_CAP + r] = tok; RSROW[(size_t)e * RT_CAP + r] = sRS[lt]; }
}
__device__ __forceinline__ void build_offsets(Frame& F) {
    LAS int* off = (LAS int*)(F.lds + EX_OFF); LAS int* cntl = (LAS int*)(F.lds + EX_CNT); LAS int* te = (LAS int*)(F.lds + EX_TE);
    if (F.wave == 0) {
        const int lane = F.lane; const int c = lane < 32 ? (int)__hip_atomic_load(F.ctl + CW_CUR + lane, RLX_AGENT) : 0;
        const int tiles = (c + 255) >> 8; int incl = tiles;
#pragma unroll
        for (int o = 1; o < 64; o <<= 1) { const int y = __shfl_up(incl, o); if (lane >= o) incl += y; }
        if (lane < 32) { off[lane + 1] = incl * 256; cntl[lane] = c; } if (lane == 0) off[0] = 0;
    }
    __syncthreads();
    for (int pm = F.tid; pm < MAXT; pm += NWAVES * 64) { int e = 0;
        for (int k = 1; k < 32; ++k) if (pm * 256 >= off[k]) e = k;
        te[pm] = e; }
    __syncthreads();
}
__device__ __forceinline__ void p13_final(Frame& F, bool with_moe) {
    float* outp = F.out; const bf16* X1B = (const bf16*)(F.ws + WS_X1B); const unsigned char* Y = (const unsigned char*)(F.ws + WS_Y)  ; const int* POSR = (const int*)(F.ws + SM_POS); const int* EID = (const int*)(F.ws + SM_EID); const float* GATE = (const float*)(F.ws + SM_GATE);
    const float* gf = F.in[I_NORMFG]; const LAS int* off = (const LAS int*)(F.lds + EX_OFF);
    const int lane = F.lane, gw = F.vcu * NWAVES + F.wave, NGW = F.G * NWAVES;
    f32x4 gg[4];
#pragma unroll
    for (int j = 0; j < 4; ++j) gg[j] = ((const GAS f32x4*)gf + lane)[64 * j];
    for (int tok0 = gw; tok0 < M; tok0 += 4 * NGW) {
        f32x4 v[4][4]; unsigned ya[4][4], yb[4][4]; float q0[4], q1[4];
#pragma unroll
        for (int q = 0; q < 4; ++q) { const int tok = tok0 + q * NGW; const bool ok = tok < M; const int tk = ok ? tok : 0;
            const GAS v2u* xr = (const GAS v2u*)(X1B + (size_t)tk * D) + lane;
#pragma unroll
            for (int j = 0; j < 4; ++j) { const v2u w = __builtin_nontemporal_load(&xr[64 * j]); v[q][j] = (f32x4){bflo(w.x), bfhi(w.x), bflo(w.y), bfhi(w.y)}; }
            if (with_moe) {
                const int p0 = off[EID[(size_t)tk * 2]] + POSR[(size_t)tk * 2], p1 = off[EID[(size_t)tk * 2 + 1]] + POSR[(size_t)tk * 2 + 1]; q0[q] = GATE[(size_t)tk * 2]; q1[q] = GATE[(size_t)tk * 2 + 1];
                const GAS unsigned* y0 = (const GAS unsigned*)(Y + (size_t)p0 * D) + lane; const GAS unsigned* y1 = (const GAS unsigned*)(Y + (size_t)p1 * D) + lane;
#pragma unroll
                for (int j = 0; j < 4; ++j) { ya[q][j] = __builtin_nontemporal_load(&y0[64 * j]); yb[q][j] = __builtin_nontemporal_load(&y1[64 * j]); }
            }
        }
#pragma unroll
        for (int q = 0; q < 4; ++q) { const int tok = tok0 + q * NGW; if (tok >= M) break;
            if (with_moe) {
#pragma unroll
                for (int j = 0; j < 4; ++j) { typedef float f32x2_ __attribute__((ext_vector_type(2)));
                    const f32x2_ a0 = __builtin_amdgcn_cvt_pk_f32_fp8((int)ya[q][j], false), a1 = __builtin_amdgcn_cvt_pk_f32_fp8((int)ya[q][j], true), b0 = __builtin_amdgcn_cvt_pk_f32_fp8((int)yb[q][j], false), b1 = __builtin_amdgcn_cvt_pk_f32_fp8((int)yb[q][j], true);
                    v[q][j].x += q0[q] * a0.x + q1[q] * b0.x; v[q][j].y += q0[q] * a0.y + q1[q] * b0.y; v[q][j].z += q0[q] * a1.x + q1[q] * b1.x; v[q][j].w += q0[q] * a1.y + q1[q] * b1.y; }
            }
            float s = 0.f;
#pragma unroll
            for (int j = 0; j < 4; ++j) s += (v[q][j].x * v[q][j].x + v[q][j].y * v[q][j].y) + (v[q][j].z * v[q][j].z + v[q][j].w * v[q][j].w);
            const float rs = 1.0f / sqrtf(wave_sum(s) * (1.f / D) + EPS_RMS);
            GAS f32x4* xw = (GAS f32x4*)(outp + (size_t)tok * D) + lane;
#pragma unroll
            for (int j = 0; j < 4; ++j) { f32x4 o; o.x = v[q][j].x * rs * gg[j].x; o.y = v[q][j].y * rs * gg[j].y; o.z = v[q][j].z * rs * gg[j].z; o.w = v[q][j].w * rs * gg[j].w; __builtin_nontemporal_store(o, &xw[64 * j]); }
        }
    }
}
__device__ __forceinline__ void copy_x_to_out(Frame& F) {
    const int gt = (F.vcu * NWAVES + F.wave) * 64 + F.lane, NT = F.G * NWAVES * 64;
    const GAS f32x4* s = (const GAS f32x4*)F.in[I_X]; GAS v2u* d = (GAS v2u*)(F.ws + WS_X1B);
    for (size_t i = gt; i < (size_t)M * D / 4; i += NT) { const f32x4 v = s[i]; v2u o; o.x = pk2(v.x, v.y); o.y = pk2(v.z, v.w); d[i] = o; }
}

#ifndef EN_MIX_D
#define EN_MIX_D 1
#endif
#ifndef EN_MIX_M
#define EN_MIX_M 1
#endif
#ifndef EN_MOE
#define EN_MOE 1
#endif
__device__ __forceinline__ void p13_final_pre(Frame& F, const XcdBarrier& bar) {
    float* outp = F.out; const bf16* X1B = (const bf16*)(F.ws + WS_X1B); const unsigned char* Y = (const unsigned char*)(F.ws + WS_Y); const int* POSR = (const int*)(F.ws + SM_POS); const int* EID = (const int*)(F.ws + SM_EID); const float* GATE = (const float*)(F.ws + SM_GATE);
    const float* gf = F.in[I_NORMFG]; const LAS int* off = (const LAS int*)(F.lds + EX_OFF);
    const int lane = F.lane, gw = F.vcu * NWAVES + F.wave, NGW = F.G * NWAVES;
    xcd_barrier_arrive(bar);
    v2u xw[4][4][4];
#pragma unroll
    for (int it = 0; it < 4; ++it)
#pragma unroll
        for (int q = 0; q < 4; ++q) { const int tok = gw + (4 * it + q) * NGW; const GAS v2u* xr = (const GAS v2u*)(X1B + (size_t)tok * D) + lane;
#pragma unroll
            for (int j = 0; j < 4; ++j) xw[it][q][j] = __builtin_nontemporal_load(&xr[64 * j]); }
    xcd_barrier_wait(bar);
    f32x4 gg[4];
#pragma unroll
    for (int j = 0; j < 4; ++j) gg[j] = ((const GAS f32x4*)gf + lane)[64 * j];
#pragma unroll
    for (int it = 0; it < 4; ++it) {
        unsigned ya[4][4], yb[4][4]; float q0[4], q1[4];
#pragma unroll
        for (int q = 0; q < 4; ++q) { const int tk = gw + (4 * it + q) * NGW;
            const int p0 = off[EID[(size_t)tk * 2]] + POSR[(size_t)tk * 2], p1 = off[EID[(size_t)tk * 2 + 1]] + POSR[(size_t)tk * 2 + 1]; q0[q] = GATE[(size_t)tk * 2]; q1[q] = GATE[(size_t)tk * 2 + 1];
            const GAS unsigned* y0 = (const GAS unsigned*)(Y + (size_t)p0 * D) + lane; const GAS unsigned* y1 = (const GAS unsigned*)(Y + (size_t)p1 * D) + lane;
#pragma unroll
            for (int j = 0; j < 4; ++j) { ya[q][j] = __builtin_nontemporal_load(&y0[64 * j]); yb[q][j] = __builtin_nontemporal_load(&y1[64 * j]); } }
#pragma unroll
        for (int q = 0; q < 4; ++q) { const int tok = gw + (4 * it + q) * NGW; f32x4 v[4];
#pragma unroll
            for (int j = 0; j < 4; ++j) { typedef float f32x2_ __attribute__((ext_vector_type(2))); const v2u w = xw[it][q][j];
                const f32x2_ a0 = __builtin_amdgcn_cvt_pk_f32_fp8((int)ya[q][j], false), a1 = __builtin_amdgcn_cvt_pk_f32_fp8((int)ya[q][j], true), b0 = __builtin_amdgcn_cvt_pk_f32_fp8((int)yb[q][j], false), b1 = __builtin_amdgcn_cvt_pk_f32_fp8((int)yb[q][j], true);
                v[j].x = bflo(w.x) + (q0[q] * a0.x + q1[q] * b0.x); v[j].y = bfhi(w.x) + (q0[q] * a0.y + q1[q] * b0.y); v[j].z = bflo(w.y) + (q0[q] * a1.x + q1[q] * b1.x); v[j].w = bfhi(w.y) + (q0[q] * a1.y + q1[q] * b1.y); }
            float s_ = 0.f;
#pragma unroll
            for (int j = 0; j < 4; ++j) s_ += (v[j].x * v[j].x + v[j].y * v[j].y) + (v[j].z * v[j].z + v[j].w * v[j].w);
            const float rs = 1.0f / sqrtf(wave_sum(s_) * (1.f / D) + EPS_RMS);
            GAS f32x4* xo = (GAS f32x4*)(outp + (size_t)tok * D) + lane;
#pragma unroll
            for (int j = 0; j < 4; ++j) { f32x4 o; o.x = v[j].x * rs * gg[j].x; o.y = v[j].y * rs * gg[j].y; o.z = v[j].z * rs * gg[j].z; o.w = v[j].w * rs * gg[j].w; __builtin_nontemporal_store(o, &xo[64 * j]); } }
    }
}
constexpr int N_PHASES = 14;
struct Args { const float* in[24]; float* out; unsigned char* ws; int ph_lo, ph_hi, rep_mask, pad; };
__global__ void __launch_bounds__(NWAVES * 64, 2) fwd_kernel(Args args) {
    extern __shared__ __attribute__((aligned(16))) unsigned char lds[];
    Frame F;
    F.lds = (LAS unsigned char*)lds;
    F.MISC = (volatile LAS unsigned*)(F.lds + MISC_OFF);
    F.tid = threadIdx.x; F.lane = F.tid & 63; F.wave = __builtin_amdgcn_readfirstlane(F.tid >> 6);
    F.G = gridDim.x; { const int bx = blockIdx.x; F.vcu = (F.G % 8 == 0) ? (bx % 8) * (F.G / 8) + bx / 8 : bx; }
    F.ws = args.ws; F.ctl = (gu32*)(args.ws + WS_CTL); F.out = args.out; F.rep9 = REPS(9);
#pragma unroll
    for (int i = 0; i < 24; ++i) F.in[i] = args.in[i];
    for (int u = F.tid; u < 128; u += NWAVES * 64) ((LAS unsigned*)(F.lds + LDSCTL_OFF))[u] = 0u;
    __syncthreads();
    XcdBarrier bar; bar.bar = (unsigned*)(F.ctl + CW_BAR); bar.x = 0; bar.st = nullptr;
    if (!MK_PER_PHASE) bar = xcd_barrier_post((unsigned*)(F.ctl + CW_BAR), F.MISC + 8);
    const int lo = args.ph_lo, hi = args.ph_hi;
#define IN(k) (lo <= (k) && (k) < hi)
#ifndef SEAM_REP
#define SEAM_REP 1
#endif
#define SEAM(k) do { if (IN(k) && IN((k) + 1)) { for (int sr_ = 0; sr_ < SEAM_REP; ++sr_) xcd_barrier(bar); } } while (0)
    unsigned char* ws = args.ws;

    if (IN(0)) { for (int rp = 0; rp < REPS(0); ++rp) p0_prologue(F); } SEAM(0);
    if (IN(1) && (EN_MIX_D || EN_MIX_M)) for (int rp = 0; rp < REPS(1); ++rp) {
        const bool f8_first = (((int)blockIdx.x) & 1) == 0;
#define P1_BF16() do {     \
            pg8::Gemm g{(const pg8::bf16_t*)(ws + WS_HB), (const pg8::bf16_t*)(ws + WS_WIN), M, 4 * DH, D, 0}; pg8::StaticOrder S; S.init(M, 4 * DH, F.G, (int)blockIdx.x); \
            pg8::EpiBf16S E{(pg8::bf16_t*)(ws + WS_PC), DH, DH, (size_t)(WS_PV - WS_PC) / 2, 3, attn_body::C2, 2, PROBE_NT_FROM, 1, 2}; \
            pg8::gemm_phase<pg8::EpiBf16S, pg8::StaticOrder, PG8_ALIGN, PG8_SP2>(F.lds + RING_OFF, g, S, E); __syncthreads(); } while (0)
        if (!f8_first) P1_BF16();
        {
            pg8::Gemm g{(const pg8::bf16_t*)(ws + WS_H8), (const pg8::bf16_t*)(ws + WS_WIN8), M, 2 * DH, D, 0}; pg8::StaticOrder S; S.init(M, 2 * DH, F.G, (int)blockIdx.x);
            pg8::EpiBf16S E{(pg8::bf16_t*)(ws + WS_PC), DH, DH, (size_t)(WS_PV - WS_PC) / 2, 3, attn_body::C2, 2, PROBE_NT_FROM, 0, 1};
            pg8::gemm_phase<pg8::EpiBf16S, pg8::StaticOrder, PG8_ALIGN, PG8_SP2, pg8::NoGather, true>(F.lds + RING_OFF, g, S, E); __syncthreads(); }
        if (f8_first) P1_BF16();
#undef P1_BF16
    } SEAM(1);
    if (IN(2) && EN_MIX_M) { for (int rp = 0; rp < REPS(2); ++rp) p2_mfront(F); }
    const bool split_ok = !MK_PER_PHASE && EN_MOE && EN_MIX_D && EN_MIX_M && IN(3) && IN(4) && IN(5) && IN(6);
    const bool split7 = split_ok && IN(7) && IN(8); const int pew_from = split_ok ? (split7 ? 2 * PEW_SH + PEW_S7 : 2 * PEW_SH) : 0;
    if (IN(3) && EN_MIX_M) { for (int rp = 0; rp < REPS(3); ++rp) p3_mlocal(F); }
    if (split_ok) { xcd_barrier_arrive(bar); p_expert_weights(F, 0, PEW_SH); xcd_barrier_wait(bar); } else SEAM(3);
    if (IN(4) && EN_MIX_M) { for (int rp = 0; rp < REPS(4); ++rp) p4_mscan(F); }
    if (!split_ok) SEAM(4);
    if (IN(5)) { if (EN_MIX_M) { for (int rp = 0; rp < REPS(5); ++rp) p5_mout(F, bar, split_ok && rp == 0, PEW_SH, 2 * PEW_SH); } else { bf16* A2 = (bf16*)((unsigned char*)F.out + OUT_A2); const int gt = (F.vcu * NWAVES + F.wave) * 64 + F.lane;
            for (size_t i = gt; i < (size_t)M * 64; i += (size_t)F.G * NWAVES * 64) { const size_t tok = i >> 6, c = i & 63; *(GAS v4u*)(A2 + tok * D + c * 8) = (v4u){0u, 0u, 0u, 0u}; } } }
    if (IN(6) && EN_MIX_D) for (int rp = 0; rp < REPS(6); ++rp) {
        const bool conv_first = (((int)blockIdx.x >> 3) & 1) == 0;
        if (EN_MOE && conv_first) { for (int rc_ = 0; rc_ < PROBE_CONVREP; ++rc_) { p_expert_weights(F, pew_from); __syncthreads(); } }
        build_dltab(F); __syncthreads();
        const attn_body::AttnTensors AT{(const attn_body::bf16*)(ws + WS_PQ), (const attn_body::bf16*)(ws + WS_PK), (const attn_body::bf16*)(ws + WS_PVD), (attn_body::bf16*)F.out};
        const attn_body::StaticOrder S((int)F.G, (int)blockIdx.x);
        attn_body::attn_phase<attn_body::StaticOrder>((char*)lds + RING_OFF, AT, S, (const LAS float*)(F.lds + EX_DL));
        if (F.G == 256) {
            asm volatile("s_waitcnt vmcnt(0)" ::: "memory"); __syncthreads();
            if (F.tid == 0) { __builtin_amdgcn_fence(__ATOMIC_ACQUIRE, "agent"); asm volatile("s_waitcnt vmcnt(0)" ::: "memory"); }
            __syncthreads();
            const int p_ = F.vcu & 7, bh_ = F.vcu >> 3;
#pragma nounroll
            for (int k_ = 0; k_ < 2; ++k_) p7_local(F, bh_ >> 2, bh_ & 3, k_ ? p_ : 15 - p_);
        }
        if (EN_MOE && !conv_first) { for (int rc_ = 0; rc_ < PROBE_CONVREP; ++rc_) { __syncthreads(); p_expert_weights(F, pew_from); } }
    } if (F.G != 256) SEAM(6);
    if (IN(7)) { if (EN_MIX_D) { if (F.G != 256) for (int rp = 0; rp < REPS(7); ++rp) p7_combine(F); } else { bf16* A2 = (bf16*)((unsigned char*)F.out + OUT_A2); const int gt = (F.vcu * NWAVES + F.wave) * 64 + F.lane;
            for (size_t i = gt; i < (size_t)M * 64; i += (size_t)F.G * NWAVES * 64) { const size_t tok = i >> 6, c = i & 63; *(GAS v4u*)(A2 + tok * D + DH + c * 8) = (v4u){0u, 0u, 0u, 0u}; } } }
    if (split7) { xcd_barrier_arrive(bar); p_expert_weights(F, 2 * PEW_SH, 2 * PEW_SH + PEW_S7); xcd_barrier_wait(bar); } else SEAM(7);
    if (IN(8)) for (int rp = 0; rp < REPS(8); ++rp) {
        if (EN_MIX_D || EN_MIX_M) {
            pg8::Gemm g{(const pg8::bf16_t*)((unsigned char*)F.out + OUT_A2), (const pg8::bf16_t*)(ws + WS_WOUT), M, D, D, 0}; pg8::StaticOrder S; S.init(M, D, F.G, (int)blockIdx.x);
            pg8::EpiResBf16 E{(const pg8::bf16_t*)(ws + WS_HB), (const float*)(ws + SM_RMS1), (pg8::bf16_t*)(ws + WS_X1B), D, (unsigned char*)(ws + WS_X1F8)};
            pg8::gemm_phase<pg8::EpiResBf16, pg8::StaticOrder, PG8_ALIGN, PG8_SP2>(F.lds + RING_OFF, g, S, E);
            if (EN_MOE && IN(9) && MK_PER_PHASE) { __syncthreads(); p9_prep(F); }
        } else copy_x_to_out(F);
    }
    if (!MK_PER_PHASE && IN(8) && IN(9) && EN_MOE && (EN_MIX_D || EN_MIX_M)) { xcd_barrier_arrive(bar); p9_prep(F); xcd_barrier_wait(bar); } else SEAM(8);
    if (IN(9) && EN_MOE) { p9_router(F, IN(8) && (EN_MIX_D || EN_MIX_M)); } SEAM(9);
    if (IN(10) && EN_MOE) { build_offsets(F); }
    if (IN(11) && EN_MOE) for (int rp = 0; rp < REPS(11); ++rp) {
        if (MK_PER_PHASE || !(IN(10))) build_offsets(F);
        const int T = ((LAS int*)(F.lds + EX_OFF))[32] >> 8;
        pg8::Gemm g{(const pg8::bf16_t*)(ws + WS_X1F8), (const pg8::bf16_t*)(ws + WS_WGU), T * 256, D, D, (size_t)D * D}; pg8::GroupedOrder S; S.init(T, D, F.G, (int)blockIdx.x, (const LAS int*)(F.lds + EX_TE));
        pg8::EpiSwiGLU E{(unsigned char*)(ws + WS_HID), FFE, (const float*)(ws + WS_RS), (const LAS int*)(F.lds + EX_OFF), RT_CAP};
        pg8::RowGather GT{(const int*)(ws + WS_RT), (const LAS int*)(F.lds + EX_OFF), (const LAS int*)(F.lds + EX_CNT), RT_CAP};
        pg8::gemm_phase<pg8::EpiSwiGLU, pg8::GroupedOrder, PG8_ALIGN, PG8_SP2, pg8::RowGather, true>(F.lds + RING_OFF, g, S, E, GT);
    } SEAM(11);
    if (IN(12) && EN_MOE) for (int rp = 0; rp < REPS(12); ++rp) {
        if (MK_PER_PHASE || !(IN(10))) build_offsets(F);
        const int T = ((LAS int*)(F.lds + EX_OFF))[32] >> 8;
        pg8::Gemm g{(const pg8::bf16_t*)(ws + WS_HID), (const pg8::bf16_t*)(ws + WS_WD), T * 256, D, FFE, (size_t)D * FFE}; pg8::GroupedOrder S; S.init(T, D, F.G, (int)blockIdx.x, (const LAS int*)(F.lds + EX_TE));
        pg8::EpiFp8 E{(unsigned char*)(ws + WS_Y), D};
#ifdef PROBE_NOSTORE12
        E.nostore = rp;
#endif
        pg8::gemm_phase<pg8::EpiFp8, pg8::GroupedOrder, PG8_ALIGN, PG8_SP2, pg8::NoGather, true>(F.lds + RING_OFF, g, S, E);
    }
    if (!MK_PER_PHASE && EN_MOE && lo == 0 && hi == N_PHASES && F.G == 256) p13_final_pre(F, bar);
    else { SEAM(12); if (IN(13)) { if (EN_MOE && (MK_PER_PHASE || !(IN(10)))) build_offsets(F); p13_final(F, EN_MOE != 0); } }
#undef IN
#undef SEAM
}

extern "C" void kernel_launch(void* const* d_in, const int* in_sizes, int n_in, void* d_out, int out_size, void* d_ws, size_t ws_size, hipStream_t stream) {
    static int grid = 0;
    if (grid == 0) {
        if (n_in != 24 || in_sizes[0] != M * D || out_size != M * D || ws_size < WS_END) { fprintf(stderr, "kernel_launch: unexpected shapes (n_in %d, in0 %d, out %d, ws %zu); nothing launched\n", n_in, n_in > 0 ? in_sizes[0] : -1, out_size, ws_size); grid = -1; return; }
        int dev = 0, cus = 0, per_cu = 0;
        if (hipGetDevice(&dev) != hipSuccess || hipDeviceGetAttribute(&cus, hipDeviceAttributeMultiprocessorCount, dev) != hipSuccess) { grid = -1; return; }
        if (hipFuncSetAttribute((const void*)fwd_kernel, hipFuncAttributeMaxDynamicSharedMemorySize, LDS_BYTES) != hipSuccess) { fprintf(stderr, "kernel_launch: hipFuncSetAttribute failed\n"); grid = -1; return; }
        if (hipOccupancyMaxActiveBlocksPerMultiprocessor(&per_cu, (const void*)fwd_kernel, NWAVES * 64, LDS_BYTES) != hipSuccess || per_cu < 1) fprintf(stderr, "kernel_launch: occupancy query reports %d\n", per_cu);
        (void)hipGetLastError();
        grid = cus;
    }
    if (grid < 0) return;
    if (hipMemsetAsync((char*)d_ws + WS_CTL, 0, CTL_ZERO_BYTES, stream) != hipSuccess) return;
    Args a{};
    for (int i = 0; i < 24; ++i) a.in[i] = (const float*)d_in[i];
    a.out = (float*)d_out; a.ws = (unsigned char*)d_ws; a.rep_mask = REP_MASK; a.pad = 0;
#if MK_PER_PHASE
    for (int p = 0; p < N_PHASES; ++p) { a.ph_lo = p; a.ph_hi = p + 1; hipLaunchKernelGGL(fwd_kernel, dim3(grid), dim3(NWAVES * 64), LDS_BYTES, stream, a); }
#else
    a.ph_lo = 0; a.ph_hi = N_PHASES;
    hipLaunchKernelGGL(fwd_kernel, dim3(grid), dim3(NWAVES * 64), LDS_BYTES, stream, a);
#endif
}
```
